# Optimizing an MI355X kernel written in HIP

```python
import jax, jax.numpy as jnp
from jax import lax
import numpy as np

D_MODEL = 1024
BATCH = 2
SEQ = 16384
DEPTH = 1

GRID_W = 64
CTX_LEN = 256
RET_HEADS = 4
RET_QK_DIM = 256
RET_V_DIM = 512
RET_CHUNK = 128
CONV_DIM = D_MODEL
CONV_WIDTH = 31
D_FF = 2816
ROPE_BASE = 10000.0
EPS = 1e-6
N_MOD = 9

RET_QK_W = RET_HEADS * RET_QK_DIM
RET_V_W = RET_HEADS * RET_V_DIM
K0 = RET_QK_W
V0 = 2 * RET_QK_W
G0 = V0 + RET_V_W
C0 = G0 + RET_V_W
GA0 = C0 + 2 * CONV_DIM
GB0 = GA0 + D_MODEL
IN_WIDTH = GB0 + D_MODEL
IN_SPLITS = (K0, V0, G0, C0, GA0, GB0)

kernel_name = 'hybrid_retention_conformer_dit'

F32 = jnp.float32


def rmsnorm(x, w):
    xf = x.astype(F32)
    y = xf * lax.rsqrt(jnp.mean(xf * xf, axis=-1, keepdims=True) + EPS)
    return (y * w.astype(F32)).astype(x.dtype)


def layernorm(x, w, b):
    xf = x.astype(F32)
    mu = jnp.mean(xf, axis=-1, keepdims=True)
    var = jnp.mean(jnp.square(xf - mu), axis=-1, keepdims=True)
    y = (xf - mu) * lax.rsqrt(var + EPS)
    return (y * w.astype(F32) + b.astype(F32)).astype(x.dtype)


def modulate(x, w, shift, scale):
    return rmsnorm(x, w) * (1 + scale) + shift


def swiglu(x, w_in, w_out):
    a, b = jnp.split(x @ w_in, 2, axis=-1)
    return (jax.nn.silu(a) * b) @ w_out


def heads(t, d):
    return t.reshape(t.shape[0], t.shape[1], RET_HEADS, d)


def rotate_block(x, ang):
    x1, x2 = jnp.split(x, 2, axis=-1)
    cos = jnp.cos(ang)[None, :, None, :]
    sin = jnp.sin(ang)[None, :, None, :]
    return jnp.concatenate([x1 * cos - x2 * sin, x1 * sin + x2 * cos], axis=-1)


def rope_2d(x, rows, cols):
    half = x.shape[-1] // 2
    inv = ROPE_BASE ** (-jnp.arange(0, half, 2, dtype=F32) / half)
    xr, xc = jnp.split(x.astype(F32), 2, axis=-1)
    out = jnp.concatenate([rotate_block(xr, rows[:, None] * inv[None, :]),
                           rotate_block(xc, cols[:, None] * inv[None, :])], axis=-1)
    return out.astype(x.dtype)


def retention_dir(q, k, v, log_g, state0, strict):
    b, L, h, dk = q.shape
    dv = v.shape[-1]
    n = L // RET_CHUNK
    qc = q.astype(F32).reshape(b, n, RET_CHUNK, h, dk)
    kc = k.astype(F32).reshape(b, n, RET_CHUNK, h, dk)
    vc = v.astype(F32).reshape(b, n, RET_CHUNK, h, dv)
    pos = jnp.arange(RET_CHUNK, dtype=F32)
    diff = pos[:, None] - pos[None, :]
    mask = (diff > 0) if strict else (diff >= 0)
    intra = jnp.where(mask[None], jnp.exp(log_g[:, None, None] * jnp.maximum(diff, 0.0)[None]), 0.0)
    scores = jnp.einsum('bnchd,bnshd->bnhcs', qc, kc) * intra[None, None]
    inner = jnp.einsum('bnhcs,bnshe->bnche', scores, vc)
    q_dec = jnp.exp(log_g[None, :] * (pos[:, None] + 1.0))
    k_dec = jnp.exp(log_g[None, :] * (RET_CHUNK - 1.0 - pos)[:, None])
    c_dec = jnp.exp(log_g * RET_CHUNK)

    def step(state, xs):
        qi, ki, vi = xs
        cross = jnp.einsum('bchd,bhde->bche', qi, state) * q_dec[None, :, :, None]
        upd = jnp.einsum('bshd,bshe->bhde', ki * k_dec[None, :, :, None], vi)
        return state * c_dec[None, :, None, None] + upd, cross

    state, cross = lax.scan(step, state0, (qc.swapaxes(0, 1), kc.swapaxes(0, 1), vc.swapaxes(0, 1)))
    out = (inner + cross.swapaxes(0, 1)).reshape(b, L, h, dv)
    return out.astype(v.dtype), state


def bidir_retention(q, k, v, log_gf, log_gb, rf0, rb0):
    out_f, rf = retention_dir(q, k, v, log_gf, rf0, False)
    out_b, rb = retention_dir(q[:, ::-1], k[:, ::-1], v[:, ::-1], log_gb, rb0, True)
    return out_f + out_b[:, ::-1], rf, rb


def context_state(k, v, log_g, reverse):
    L = k.shape[1]
    pos = jnp.arange(L, dtype=F32)
    expo = pos if reverse else (L - 1.0) - pos
    w = jnp.exp(expo[:, None] * log_g[None, :])
    return jnp.einsum('blhd,blhe->bhde', k.astype(F32) * w[None, :, :, None], v.astype(F32))


def retention_branch(o, gate, gn_w, w_o):
    b, L, h, dv = o.shape
    of = o.astype(F32)
    mu = jnp.mean(of, axis=-1, keepdims=True)
    var = jnp.mean(jnp.square(of - mu), axis=-1, keepdims=True)
    of = ((of - mu) * lax.rsqrt(var + EPS)).reshape(b, L, h * dv) * gn_w.astype(F32)
    return (jax.nn.silu(gate) * of.astype(gate.dtype)) @ w_o


def conv_branch(z, conv_w, conv_b, ln_w, ln_b, w_pw):
    a, g = jnp.split(z, 2, axis=-1)
    y = a * jax.nn.sigmoid(g)
    pad = CONV_WIDTH // 2
    y = lax.conv_general_dilated(y, conv_w[:, None, :].astype(y.dtype), window_strides=(1,),
                                 padding=[(pad, pad)], dimension_numbers=('NWC', 'WIO', 'NWC'),
                                 feature_group_count=CONV_DIM) + conv_b
    y = jax.nn.silu(layernorm(y, ln_w, ln_b))
    return y @ w_pw


def mixer_output(ret_out, rg, cv, ga, gb, gn_w, w_ret_o, conv_w, conv_b, ln_w, ln_b, w_conv_o, w_o):
    y_ret = retention_branch(ret_out, rg, gn_w, w_ret_o)
    y_conv = conv_branch(cv, conv_w, conv_b, ln_w, ln_b, w_conv_o)
    return (jax.nn.sigmoid(ga) * y_ret + jax.nn.sigmoid(gb) * y_conv) @ w_o


def setup_inputs(seed: int = 0) -> dict:
    key = jax.random.key(seed)
    ks = jax.random.split(key, 32)

    def nrm(k, shape, scale):
        return jax.random.normal(k, shape, F32) * scale

    decay_logit = jnp.asarray(np.log(2.0 ** (5.0 + np.arange(RET_HEADS)) - 1.0), F32)
    return {
        'x': nrm(ks[0], (BATCH, SEQ, D_MODEL), 1.0),
        'c': nrm(ks[1], (BATCH, D_MODEL), 1.0),
        'ctx': nrm(ks[2], (BATCH, CTX_LEN, D_MODEL), 1.0),
        'c_ctx': nrm(ks[3], (D_MODEL,), 1.0),
        'w_mod': nrm(ks[4], (DEPTH, D_MODEL, N_MOD * D_MODEL), 0.5 * D_MODEL ** -0.5),
        'b_mod': nrm(ks[5], (DEPTH, N_MOD * D_MODEL), 0.01),
        'norm_ffn1': 1.0 + nrm(ks[6], (DEPTH, D_MODEL), 0.01),
        'w_ffn1_in': nrm(ks[7], (DEPTH, D_MODEL, 2 * D_FF), D_MODEL ** -0.5),
        'w_ffn1_out': nrm(ks[8], (DEPTH, D_FF, D_MODEL), D_FF ** -0.5),
        'norm_mix': 1.0 + nrm(ks[9], (DEPTH, D_MODEL), 0.01),
        'w_in': nrm(ks[10], (DEPTH, D_MODEL, IN_WIDTH), D_MODEL ** -0.5),
        'ret_decay_f': decay_logit[None, :] + nrm(ks[11], (DEPTH, RET_HEADS), 0.1),
        'ret_decay_b': decay_logit[None, :] + nrm(ks[12], (DEPTH, RET_HEADS), 0.1),
        'ret_gn_w': 1.0 + nrm(ks[13], (DEPTH, RET_V_W), 0.01),
        'w_ret_out': nrm(ks[14], (DEPTH, RET_V_W, D_MODEL), RET_V_W ** -0.5),
        'conv_w': nrm(ks[15], (DEPTH, CONV_WIDTH, CONV_DIM), CONV_WIDTH ** -0.5),
        'conv_b': nrm(ks[16], (DEPTH, CONV_DIM), 0.01),
        'conv_ln_w': 1.0 + nrm(ks[17], (DEPTH, CONV_DIM), 0.01),
        'conv_ln_b': nrm(ks[18], (DEPTH, CONV_DIM), 0.01),
        'w_conv_out': nrm(ks[19], (DEPTH, CONV_DIM, D_MODEL), CONV_DIM ** -0.5),
        'w_out': nrm(ks[20], (DEPTH, D_MODEL, D_MODEL), D_MODEL ** -0.5),
        'norm_ffn2': 1.0 + nrm(ks[21], (DEPTH, D_MODEL), 0.01),
        'w_ffn2_in': nrm(ks[22], (DEPTH, D_MODEL, 2 * D_FF), D_MODEL ** -0.5),
        'w_ffn2_out': nrm(ks[23], (DEPTH, D_FF, D_MODEL), D_FF ** -0.5),
        'final_norm': 1.0 + nrm(ks[24], (D_MODEL,), 0.01),
    }


def reference(x, c, ctx, c_ctx, w_mod, b_mod, norm_ffn1, w_ffn1_in, w_ffn1_out, norm_mix, w_in,
              ret_decay_f, ret_decay_b, ret_gn_w, w_ret_out, conv_w, conv_b, conv_ln_w, conv_ln_b,
              w_conv_out, w_out, norm_ffn2, w_ffn2_in, w_ffn2_out, final_norm):
    B, L, _ = x.shape
    ROWS = L // GRID_W
    rows = jnp.repeat(jnp.arange(ROWS, dtype=F32), GRID_W)
    cols = jnp.tile(jnp.arange(GRID_W, dtype=F32), ROWS)
    qk_scale = RET_QK_DIM ** -0.5
    h, hc = x, ctx
    for layer in range(DEPTH):
        last = layer + 1 == DEPTH
        mods = jnp.split((jax.nn.silu(c) @ w_mod[layer] + b_mod[layer])[:, None, :], N_MOD, axis=-1)
        mods_c = jnp.split(jax.nn.silu(c_ctx) @ w_mod[layer] + b_mod[layer], N_MOD, axis=-1)
        sh1, sc1, g1, sh2, sc2, g2, sh3, sc3, g3 = mods
        sh1c, sc1c, g1c, sh2c, sc2c, g2c, sh3c, sc3c, g3c = mods_c

        h = h + 0.5 * g1 * swiglu(modulate(h, norm_ffn1[layer], sh1, sc1), w_ffn1_in[layer], w_ffn1_out[layer])
        hc = hc + 0.5 * g1c * swiglu(modulate(hc, norm_ffn1[layer], sh1c, sc1c), w_ffn1_in[layer], w_ffn1_out[layer])

        u = modulate(h, norm_mix[layer], sh2, sc2)
        uc = modulate(hc, norm_mix[layer], sh2c, sc2c)
        log_gf = jax.nn.log_sigmoid(ret_decay_f[layer].astype(F32))
        log_gb = jax.nn.log_sigmoid(ret_decay_b[layer].astype(F32))
        branch_w = (ret_gn_w[layer], w_ret_out[layer], conv_w[layer], conv_b[layer], conv_ln_w[layer],
                    conv_ln_b[layer], w_conv_out[layer], w_out[layer])

        if last:
            kv_c = uc @ w_in[layer][:, K0:G0]
            kc_, vc_ = jnp.split(kv_c, [RET_QK_W], axis=-1)
            kc_ = heads(kc_, RET_QK_DIM) * qk_scale
            vc_ = heads(vc_, RET_V_DIM)
            rf = context_state(kc_, vc_, log_gf, False)
            rb = context_state(kc_, vc_, log_gb, True)
        else:
            qc_, kc_, vc_, rgc, cvc, gac, gbc = jnp.split(uc @ w_in[layer], IN_SPLITS, axis=-1)
            zeros = jnp.zeros((B, RET_HEADS, RET_QK_DIM, RET_V_DIM), F32)
            oc, rf, rb = bidir_retention(heads(qc_, RET_QK_DIM), heads(kc_, RET_QK_DIM) * qk_scale,
                                         heads(vc_, RET_V_DIM), log_gf, log_gb, zeros, zeros)
            hc = hc + g2c * mixer_output(oc, rgc, cvc, gac, gbc, *branch_w)
            hc = hc + 0.5 * g3c * swiglu(modulate(hc, norm_ffn2[layer], sh3c, sc3c), w_ffn2_in[layer], w_ffn2_out[layer])

        q, k, v, rg, cv, ga, gb = jnp.split(u @ w_in[layer], IN_SPLITS, axis=-1)
        q = rope_2d(heads(q, RET_QK_DIM), rows, cols)
        k = rope_2d(heads(k, RET_QK_DIM), rows, cols) * qk_scale
        v = heads(v, RET_V_DIM)
        o, _, _ = bidir_retention(q, k, v, log_gf, log_gb, rf, rb)
        h = h + g2 * mixer_output(o, rg, cv, ga, gb, *branch_w)

        h = h + 0.5 * g3 * swiglu(modulate(h, norm_ffn2[layer], sh3, sc3), w_ffn2_in[layer], w_ffn2_out[layer])
    return rmsnorm(h, final_norm)
```

```cpp
#include <hip/hip_runtime.h>
#include <hip/hip_cooperative_groups.h>
#include <cstdio>
#include <cstdint>
namespace cg = cooperative_groups;

#define LAS __attribute__((address_space(3)))
typedef unsigned short bf16_t;
typedef short bf16x8 __attribute__((ext_vector_type(8)));
typedef float f32x4 __attribute__((ext_vector_type(4)));
typedef float f32x2 __attribute__((ext_vector_type(2)));
typedef unsigned u32x4 __attribute__((ext_vector_type(4)));
typedef unsigned u32x2 __attribute__((ext_vector_type(2)));

constexpr int D = 1024, NB = 2, L = 16384, T = NB * L, CTXL = 256, TC = NB * CTXL, MALL = T + TC, DFF = 2816, INW = 10240, NMOD = 9;
constexpr int CH = 512, NCH = L / CH;
constexpr float EPS = 1e-6f;
constexpr size_t MiB = (size_t)1 << 20;
constexpr size_t WS_WFFN1IN = 0;
constexpr size_t WS_WFFN1OUT = WS_WFFN1IN + 11 * MiB;
constexpr size_t WS_WIN = WS_WFFN1OUT + 5 * MiB + MiB / 2;
constexpr size_t WS_WRET = WS_WIN + 20 * MiB;
constexpr size_t WS_WCONV = WS_WRET + 4 * MiB;
constexpr size_t WS_WOUT = WS_WCONV + 2 * MiB;
constexpr size_t WS_WFFN2IN = WS_WOUT + 2 * MiB;
constexpr size_t WS_WFFN2OUT = WS_WFFN2IN + 11 * MiB;
constexpr size_t WS_SMALL = 61 * MiB;
constexpr size_t WS_MODS = WS_SMALL;
constexpr size_t WS_DEC = WS_SMALL + 120 * 1024;
constexpr size_t WS_PART = WS_SMALL + 128 * 1024;
constexpr size_t WS_STATS = WS_SMALL + 1 * MiB;
constexpr size_t WS_BAR = WS_SMALL + 10 * MiB;
constexpr size_t WS_POOL = 72 * MiB;
constexpr size_t WS_XN = WS_POOL;
constexpr size_t WS_ACT = WS_POOL + 65 * MiB;
constexpr size_t WS_KTQK = WS_POOL + 65 * MiB;
constexpr size_t WS_VT = WS_POOL + 129 * MiB;
constexpr size_t WS_SB = WS_POOL + 193 * MiB;
constexpr size_t WS_PSCR = WS_POOL + 257 * MiB;
constexpr size_t WS_O = WS_POOL + 321 * MiB;
constexpr size_t WS_H = WS_O;
constexpr size_t WS_Y = WS_POOL + 65 * MiB;
constexpr size_t WS_Z = WS_POOL + 129 * MiB;
constexpr size_t WS_YR = WS_POOL + 193 * MiB;
constexpr size_t WS_YC = WS_Y;
constexpr size_t WS_SLAB = WS_O + 64 * MiB;
constexpr size_t WS_CTX = WS_POOL + 408 * MiB;
constexpr size_t CTX_STRIDE = 8 * MiB, CTX_KT = 4 * MiB, CTX_VT = 5 * MiB;
constexpr size_t WS_END = WS_POOL + 424 * MiB;

__device__ __forceinline__ unsigned pk2(float lo, float hi) { unsigned r; asm("v_cvt_pk_bf16_f32 %0, %1, %2" : "=v"(r) : "v"(lo), "v"(hi)); return r; }
__device__ __forceinline__ float bflo(unsigned u) { return __uint_as_float(u << 16); }
__device__ __forceinline__ float bfhi(unsigned u) { return __uint_as_float(u & 0xffff0000u); }
__device__ __forceinline__ float fsig(float x) { return __builtin_amdgcn_rcpf(1.0f + __builtin_amdgcn_exp2f(-1.4426950409f * x)); }
__device__ __forceinline__ float fsilu(float x) { return x * fsig(x); }
__device__ __forceinline__ float ex2(float x) { return __builtin_amdgcn_exp2f(x); }
__device__ __forceinline__ float wave_sum(float v, int lane) {
#pragma unroll
    for (int o = 1; o < 64; o <<= 1) v += __int_as_float(__builtin_amdgcn_ds_bpermute((lane ^ o) << 2, __float_as_int(v)));
    return v;
}
template <int N> __device__ __forceinline__ void wave_sum_n(float (&v)[N], int lane) {
#pragma unroll
    for (int o = 1; o < 64; o <<= 1) {
        float t[N];
#pragma unroll
        for (int i = 0; i < N; ++i) t[i] = __int_as_float(__builtin_amdgcn_ds_bpermute((lane ^ o) << 2, __float_as_int(v[i])));
#pragma unroll
        for (int i = 0; i < N; ++i) v[i] += t[i];
    }
}
__device__ __forceinline__ float wave_reduce16(const float (&v)[16], int lane) {
    float a[8], b[4], c[2], d;
    { const bool hi = (lane & 32) != 0;
#pragma unroll
      for (int i = 0; i < 8; ++i) { const float mine = hi ? v[8 + i] : v[i], send = hi ? v[i] : v[8 + i]; a[i] = mine + __int_as_float(__builtin_amdgcn_ds_bpermute((lane ^ 32) << 2, __float_as_int(send))); } }
    { const bool hi = (lane & 16) != 0;
#pragma unroll
      for (int i = 0; i < 4; ++i) { const float mine = hi ? a[4 + i] : a[i], send = hi ? a[i] : a[4 + i]; b[i] = mine + __int_as_float(__builtin_amdgcn_ds_bpermute((lane ^ 16) << 2, __float_as_int(send))); } }
    { const bool hi = (lane & 8) != 0;
#pragma unroll
      for (int i = 0; i < 2; ++i) { const float mine = hi ? b[2 + i] : b[i], send = hi ? b[i] : b[2 + i]; c[i] = mine + __int_as_float(__builtin_amdgcn_ds_bpermute((lane ^ 8) << 2, __float_as_int(send))); } }
    { const bool hi = (lane & 4) != 0; const float mine = hi ? c[1] : c[0], send = hi ? c[0] : c[1]; d = mine + __int_as_float(__builtin_amdgcn_ds_bpermute((lane ^ 4) << 2, __float_as_int(send))); }
    d += __int_as_float(__builtin_amdgcn_ds_bpermute((lane ^ 2) << 2, __float_as_int(d)));
    d += __int_as_float(__builtin_amdgcn_ds_bpermute((lane ^ 1) << 2, __float_as_int(d)));
    return d;
}
__device__ __forceinline__ u32x4 pack8(const f32x4 a, const f32x4 b) { u32x4 w; w.x = pk2(a[0], a[1]); w.y = pk2(a[2], a[3]); w.z = pk2(b[0], b[1]); w.w = pk2(b[2], b[3]); return w; }
__device__ __forceinline__ void unpack8(const u32x4 w, f32x4& a, f32x4& b) { a[0] = bflo(w.x); a[1] = bfhi(w.x); a[2] = bflo(w.y); a[3] = bfhi(w.y); b[0] = bflo(w.z); b[1] = bfhi(w.z); b[2] = bflo(w.w); b[3] = bfhi(w.w); }


#define XB_TMO      128
#define XB_XCNT(j)  (256  + 64 * (j))
#define XB_XSUB(j)  (1280 + 64 * (j))
#define XB_XGEN(j)  (2304 + 64 * (j))
#define XB_TOP      3328
#define XB_TOPGEN   3392
#define XCD_BAR_WORDS 3456
#define XB_SPIN_CAP (1u << 20)
__device__ __forceinline__ unsigned xb_ld(unsigned* p)              { return __hip_atomic_load(p, __ATOMIC_RELAXED, __HIP_MEMORY_SCOPE_AGENT); }
__device__ __forceinline__ unsigned xb_add(unsigned* p, unsigned v) { return __hip_atomic_fetch_add(p, v, __ATOMIC_RELAXED, __HIP_MEMORY_SCOPE_AGENT); }
__device__ __forceinline__ unsigned xb_xcc_id() { return (unsigned)__builtin_amdgcn_s_getreg((3 << 11) | 20) & 0xFu; }
#define XB_SPIN(cond, bar) do { unsigned _sp = 0; while (cond) { __builtin_amdgcn_s_sleep(1); \
    if ((++_sp & 255u) == 0u) { if (xb_ld(&(bar)[XB_TMO])) break; if (_sp > XB_SPIN_CAP) { atomicAdd(&(bar)[XB_TMO], 1u); break; } } } } while (0)
struct XcdBarrier { unsigned* bar; unsigned x; volatile LAS unsigned* st; };
__device__ __forceinline__ void xcd_barrier_complete(unsigned* bar, unsigned x, unsigned& nloc, unsigned& nx) {
    const unsigned G = gridDim.x * gridDim.y * gridDim.z;
    unsigned sum, cnt, mine, sp = 0u;
    for (;;) {
        sum = 0u; cnt = 0u; mine = 0u;
#pragma unroll
        for (unsigned j = 0; j < 16; ++j) { const unsigned c = xb_ld(&bar[XB_XCNT(j)]); sum += c; cnt += (c > 0u) ? 1u : 0u; mine = (j == x) ? c : mine; }
        if (sum == G) break;
        __builtin_amdgcn_s_sleep(1);
        if ((++sp & 255u) == 0u) { if (xb_ld(&bar[XB_TMO])) break; if (sp > XB_SPIN_CAP) { atomicAdd(&bar[XB_TMO], 1u); break; } }
    }
    nloc = mine > 0u ? mine : 1u; nx = cnt > 0u ? cnt : 1u;
}
__device__ __forceinline__ void xcd_barrier(const XcdBarrier& b) {
    asm volatile("s_waitcnt vmcnt(0)" ::: "memory");
    __syncthreads();
    if (threadIdx.x == 0) {
        unsigned* bar = b.bar;
        __builtin_amdgcn_s_waitcnt(0);
        unsigned nloc = b.st[0], nx = b.st[1];
        if (nloc == 0u) { xcd_barrier_complete(bar, b.x, nloc, nx); b.st[0] = nloc; b.st[1] = nx; }
        const unsigned old = xb_add(&bar[XB_XSUB(b.x)], 1u);
        const unsigned gen = old / nloc;
        if (old + 1u == (gen + 1u) * nloc) {
            __builtin_amdgcn_fence(__ATOMIC_RELEASE, "agent");
            asm volatile("s_waitcnt vmcnt(0)" ::: "memory");
            const unsigned og = xb_add(&bar[XB_TOP], 1u);
            const unsigned tg = og / nx;
            if (og + 1u == (tg + 1u) * nx) xb_add(&bar[XB_TOPGEN], 1u);
            else XB_SPIN(xb_ld(&bar[XB_TOPGEN]) == tg, bar);
            __builtin_amdgcn_fence(__ATOMIC_ACQUIRE, "agent");
            xb_add(&bar[XB_XGEN(b.x)], 1u);
            asm volatile("s_waitcnt vmcnt(0)" ::: "memory");
        } else {
            XB_SPIN(xb_ld(&bar[XB_XGEN(b.x)]) == gen, bar);
            __builtin_amdgcn_fence(__ATOMIC_ACQUIRE, "agent");
            asm volatile("s_waitcnt vmcnt(0)" ::: "memory");
        }
    }
    __syncthreads();
}

constexpr int BM = 256, BK = 64, HALF = 128, HTB = HALF * BK * 2, STAGE_BYTES = 8 * HTB, NXCD = 8, WGM = 8;
__device__ __forceinline__ int lds_byte(int r, int c) { const int st = (r >> 4) * 2 + (c >> 5), rr = r & 15, cc = c & 31, ob = rr * 64 + cc * 2; return st * 1024 + (ob ^ (((ob >> 9) & 1) << 5)); }
__device__ __forceinline__ void stage_rc(int b, int& R, int& C) { const int st = b / 1024, sb = b % 1024, swz = sb ^ (((sb >> 9) & 1) << 5); R = (st >> 1) * 16 + swz / 64; C = (st & 1) * 32 + (swz % 64) / 2; }
__device__ __forceinline__ int perm32(int rho) { const int n = rho >> 4, i = rho & 15; return 8 * (i >> 2) + 4 * n + (i & 3); }

struct Unit { const char* A; const char* B; int lda2, ldb2, nt, kind, pm, pn, z, w; };

__device__ __forceinline__ bool tile_of(long Lidx, int nM, int nN, int& pm, int& pn) {
    const int nwg = nM * nN; if (Lidx >= nwg) return false;
    int wgid = (int)Lidx; { const int q = nwg / NXCD, r = nwg % NXCD, xcd = wgid % NXCD, off = wgid / NXCD; wgid = (xcd < r ? xcd * (q + 1) : r * (q + 1) + (xcd - r) * q) + off; }
    const int nig = WGM * nN, gid = wgid / nig, fm = gid * WGM, gsz = (nM - fm) < WGM ? (nM - fm) : WGM;
    pm = fm + ((wgid % nig) % gsz); pn = (wgid % nig) / gsz; return true;
}
struct EpiBase { __device__ __forceinline__ void a_ready(const Unit&) const {} };

#define ROWLOC(ai, m) (128 * (ai) + 64 * wr + 16 * (m) + fr)
#define COLLOC(bj) (128 * (bj) + 32 * wc + 8 * fq)

template <class Epi, class Sched>
__device__ __forceinline__ void gemm_phase(LAS unsigned char* lds, const Sched& S, const Epi& E) {
    int tid = threadIdx.x; asm volatile("" : "+v"(tid));
    const int wid = __builtin_amdgcn_readfirstlane(tid >> 6), lane = tid & 63, wr = wid >> 2, wc = wid & 3, fr = lane & 15, fq = lane >> 4;
    int sR, sRb, sC2;
    { int R, C; stage_rc(tid * 16, R, C); sR = R; sRb = (R & ~31) + perm32(R & 31); sC2 = C * 2; }
    const size_t kstep = (size_t)(BK * 2);
    const unsigned ldsbase = (unsigned)(size_t)lds + (unsigned)wid * 1024u;
    const int aoff = lds_byte(wr * 64 + fr, fq * 8), boff = lds_byte(wc * 32 + fr, fq * 8);
#define PG8_SA(b, h) (((b) * 2 + (h)) * HTB)
#define PG8_SB(b, h) ((4 + (b) * 2 + (h)) * HTB)
#define PG8_STAGE(bufoff, gbase, voff, p64) do { _Pragma("unroll") for (int _i = 0; _i < 2; ++_i) { \
        const char* _gb = (const char*)(gbase) + (size_t)_i * (p64); const unsigned _la = ldsbase + (unsigned)(bufoff) + (unsigned)_i * 8192u; \
        asm volatile("s_mov_b32 m0, %0\n\ts_nop 0\n\tglobal_load_lds_dwordx4 %1, %2" :: "s"(_la), "v"(voff), "s"(_gb) : "memory"); } } while (0)
#define PG8_LDA(dst, b, h) do { _Pragma("unroll") for (int m = 0; m < 4; ++m) _Pragma("unroll") for (int k = 0; k < 2; ++k) dst[m][k] = *(const LAS bf16x8*)(lds + PG8_SA(b, h) + aoff + m * 2048 + k * 1024); } while (0)
#define PG8_LDB(dst, b, h) do { _Pragma("unroll") for (int n = 0; n < 2; ++n) _Pragma("unroll") for (int k = 0; k < 2; ++k) dst[n][k] = *(const LAS bf16x8*)(lds + PG8_SB(b, h) + boff + n * 2048 + k * 1024); } while (0)
#define PG8_MMA(ai, bj, At, Bt) do { __builtin_amdgcn_s_setprio(1); _Pragma("unroll") for (int m = 0; m < 4; ++m) _Pragma("unroll") for (int n = 0; n < 2; ++n) _Pragma("unroll") for (int k = 0; k < 2; ++k) \
        acc[ai][bj][m][n] = __builtin_amdgcn_mfma_f32_16x16x32_bf16(Bt[n][k], At[m][k], acc[ai][bj][m][n], 0, 0, 0); __builtin_amdgcn_s_setprio(0); } while (0)
#define PG8_WAIT_V(n) asm volatile("s_waitcnt vmcnt(" #n ")" ::: "memory")
#define PG8_WAIT_L(n) asm volatile("s_waitcnt lgkmcnt(" #n ")" ::: "memory")
#define PG8_BAR __builtin_amdgcn_s_barrier()
#define PG8_SCHED __builtin_amdgcn_sched_barrier(0)
    int ui = 0;
    const char* cA; const char* cB; unsigned hA, hB; int nt; unsigned voffA, voffB;
    { Unit u0; if (!S.next(0, u0)) return;
      cA = u0.A; cB = u0.B; hA = (unsigned)HALF * u0.lda2; hB = (unsigned)HALF * u0.ldb2; nt = u0.nt;
      voffA = (unsigned)(sR * u0.lda2 + sC2); voffB = (unsigned)(sRb * u0.ldb2 + sC2); }
    f32x4 acc[2][2][4][2];
#pragma unroll
    for (int a = 0; a < 2; ++a)
#pragma unroll
        for (int b = 0; b < 2; ++b)
#pragma unroll
            for (int m = 0; m < 4; ++m)
#pragma unroll
                for (int n = 0; n < 2; ++n) acc[a][b][m][n] = (f32x4){0.f, 0.f, 0.f, 0.f};
    bf16x8 At[4][2], B0[2][2], B1[2][2];
    PG8_STAGE(PG8_SB(0, 0), cB, voffB, hB / 2); PG8_STAGE(PG8_SB(0, 1), cB + hB, voffB, hB / 2); PG8_STAGE(PG8_SA(0, 0), cA, voffA, hA / 2); PG8_STAGE(PG8_SA(0, 1), cA + hA, voffA, hA / 2);
    if (wr == 1) PG8_BAR;
    PG8_WAIT_V(2); PG8_BAR;
    PG8_STAGE(PG8_SB(1, 0), cB + kstep, voffB, hB / 2); PG8_STAGE(PG8_SA(1, 0), cA + kstep, voffA, hA / 2); PG8_STAGE(PG8_SB(1, 1), cB + hB + kstep, voffB, hB / 2);
    PG8_WAIT_V(6); PG8_BAR;
    for (;;) {
        const char* nA = cA; const char* nB = cB; int nnt = nt; bool has_next;
        { Unit nx; has_next = S.next(ui + 1, nx);
          if (has_next) { nA = nx.A; nB = nx.B; nnt = nx.nt; } }
        for (int t = 0; t < nt; t += 2) {
            const bool last = (t == nt - 2);
            const char* a1 = cA + (size_t)(t + 1) * kstep;
            const char* a2 = last ? nA : cA + (size_t)(t + 2) * kstep; const char* b2 = last ? nB : cB + (size_t)(t + 2) * kstep;
            const char* a3 = a2 + kstep; const char* b3 = b2 + kstep;
            const unsigned vA2 = voffA, vB2 = voffB, hA2 = hA, hB2 = hB;
            PG8_LDB(B0, 0, 0); PG8_LDB(B1, 0, 1); PG8_SCHED; PG8_LDA(At, 0, 0); PG8_STAGE(PG8_SA(1, 1), a1 + hA, voffA, hA / 2);
            PG8_WAIT_V(8); PG8_WAIT_L(0); PG8_BAR; PG8_MMA(0, 0, At, B0); PG8_MMA(0, 1, At, B1); PG8_BAR; PG8_SCHED;
            PG8_LDA(At, 0, 1); PG8_STAGE(PG8_SB(0, 0), b2, vB2, hB2 / 2); PG8_STAGE(PG8_SB(0, 1), b2 + hB2, vB2, hB2 / 2); PG8_STAGE(PG8_SA(0, 0), a2, vA2, hA2 / 2);
            PG8_WAIT_V(8); PG8_WAIT_L(0); PG8_BAR; PG8_MMA(1, 0, At, B0); PG8_MMA(1, 1, At, B1); PG8_BAR; PG8_SCHED;
            PG8_LDB(B0, 1, 0); PG8_LDB(B1, 1, 1); PG8_SCHED; PG8_LDA(At, 1, 0); PG8_STAGE(PG8_SA(0, 1), a2 + hA2, vA2, hA2 / 2);
            PG8_WAIT_V(8); PG8_WAIT_L(0); PG8_BAR; PG8_MMA(0, 0, At, B0); PG8_MMA(0, 1, At, B1); PG8_BAR; PG8_SCHED;
            PG8_LDA(At, 1, 1); PG8_STAGE(PG8_SB(1, 0), b3, vB2, hB2 / 2); PG8_STAGE(PG8_SB(1, 1), b3 + hB2, vB2, hB2 / 2); PG8_STAGE(PG8_SA(1, 0), a3, vA2, hA2 / 2);
            PG8_WAIT_V(8); PG8_WAIT_L(0); PG8_BAR; PG8_MMA(1, 0, At, B0); PG8_MMA(1, 1, At, B1); PG8_BAR; PG8_SCHED;
        }
        if (wr == 0) PG8_BAR;
        bool keep;
        { int efr = fr, efq = fq, eui = ui; asm volatile("" : "+v"(efr), "+v"(efq), "+s"(eui));
          Unit eu; S.next(eui, eu); keep = E(acc, eu, wr, wc, efr, efq); }
        if (!has_next) break;
        if (!keep) {
#pragma unroll
            for (int a = 0; a < 2; ++a)
#pragma unroll
                for (int b = 0; b < 2; ++b)
#pragma unroll
                    for (int m = 0; m < 4; ++m)
#pragma unroll
                        for (int n = 0; n < 2; ++n) acc[a][b][m][n] = (f32x4){0.f, 0.f, 0.f, 0.f};
        }
        cA = nA; cB = nB; nt = nnt; ++ui;
        if (wr == 1) PG8_BAR;
    }
    PG8_WAIT_V(0);
    PG8_BAR;
#undef PG8_SA
#undef PG8_SB
#undef PG8_STAGE
#undef PG8_LDA
#undef PG8_LDB
#undef PG8_MMA
#undef PG8_WAIT_V
#undef PG8_WAIT_L
#undef PG8_BAR
#undef PG8_SCHED
}

struct GridSched {
    const char* A; const char* B; int lda2, ldb2, nt, nM, nN, G, c;
    __device__ __forceinline__ bool next(int i, Unit& u) const {
        int pm, pn; if (!tile_of((long)i * G + c, nM, nN, pm, pn)) return false;
        u.A = A + (size_t)pm * 256 * lda2; u.B = B + (size_t)pn * 256 * ldb2; u.lda2 = lda2; u.ldb2 = ldb2; u.nt = nt; u.kind = 0; u.pm = pm; u.pn = pn; u.z = 0; u.w = 0; return true;
    }
};
struct Ffn1OutSched {
    const char* A; const char* B; int G, c;
    __device__ __forceinline__ bool next(int i, Unit& u) const {
        const int Lx = i * G + c; u.lda2 = DFF * 2; u.ldb2 = DFF * 2; u.z = 0; u.w = 0;
        if (Lx < 512) { int pm, pn; tile_of(Lx, 128, 4, pm, pn); u.pm = pm; u.pn = pn; u.kind = 0; u.nt = DFF / 64;
            u.A = A + (size_t)pm * 256 * (DFF * 2); u.B = B + (size_t)pn * 256 * (DFF * 2); return true; }
        const int e = Lx - 512; if (e >= 88) return false;
        const int t = e / 11, ks = e % 11; u.pm = 128 + (t >> 2); u.pn = t & 3; u.kind = 1; u.nt = 4; u.w = ks;
        u.A = A + (size_t)u.pm * 256 * (DFF * 2) + ks * 512; u.B = B + (size_t)u.pn * 256 * (DFF * 2) + ks * 512; return true;
    }
};
struct USched {
    const char* vt; const char* ktf; const char* ktb; int G, c;
    __device__ __forceinline__ bool next(int i, Unit& u) const {
        const int idx = i * G + c; if (idx >= 4 * NCH * 2 * 2) return false;
        const int pm = idx & 1, dir = (idx >> 1) & 1, n = (idx >> 2) & (NCH - 1), h = idx >> 7;
        u.A = vt + ((size_t)((h * NCH + n) * 512 + pm * 256) * 512) * 2; u.B = (dir ? ktb : ktf) + ((size_t)((h * NCH + n) * 256) * 512) * 2;
        u.lda2 = CH * 2; u.ldb2 = CH * 2; u.nt = CH / 64; u.kind = dir; u.pm = pm; u.pn = n; u.z = h; u.w = 0; return true;
    }
};
struct UCtxSched {
    const char* vtc; const char* ktcf; const char* ktcb; int G, c;
    __device__ __forceinline__ bool next(int i, Unit& u) const {
        const int idx = i * G + c; if (idx >= 32) return false;
        const int pm = idx & 1, dir = (idx >> 1) & 1, h = (idx >> 2) & 3, bb = idx >> 4;
        u.A = vtc + (size_t)bb * CTX_STRIDE + ((size_t)(h * 512 + pm * 256) * CTXL) * 2; u.B = (dir ? ktcb : ktcf) + (size_t)bb * CTX_STRIDE + ((size_t)(h * 256) * CTXL) * 2;
        u.lda2 = CTXL * 2; u.ldb2 = CTXL * 2; u.nt = CTXL / 64; u.kind = dir; u.pm = pm; u.pn = 0; u.z = h; u.w = bb; return true;
    }
};
struct QKSched {
    const char* q; const char* k; int item;
    __device__ __forceinline__ bool next(int i, Unit& u) const {
        if (i >= 2) return false;
        const int ib = item & 1, h = (item >> 1) & 3, n = item >> 3;
        u.pm = ib; u.pn = n; u.z = h; u.kind = 0; u.w = i; u.lda2 = D * 2; u.ldb2 = D * 2; u.nt = 4;
        u.A = q + ((size_t)(n * CH + ib * 256) * D + h * 256) * 2; u.B = k + ((size_t)(n * CH + i * 256) * D + h * 256) * 2;
        return true;
    }
};
struct SVSched {
    const char* qa; const char* sbb; const char* vtb; const char* pscr; int item;
    __device__ __forceinline__ bool next(int i, Unit& u) const {
        if (i >= 6) return false;
        const int dvt = i >= 3 ? 1 : 0, s3 = i - 3 * dvt;
        u.pm = item & 1; u.pn = item >> 3; u.z = (item >> 1) & 3; u.kind = 1 + s3; u.w = dvt; u.lda2 = D * 2; u.ldb2 = CH * 2;
        const size_t dvo = (size_t)dvt * (256 * (size_t)CH * 2);
        u.A = s3 < 2 ? qa : pscr; u.B = (s3 < 2 ? sbb + s3 * 512 : vtb) + dvo; u.nt = s3 < 2 ? 4 : 8;
        return true;
    }
};

#define EPI_ARGS f32x4 (&acc)[2][2][4][2], const Unit& u, int wr, int wc, int fr, int fq
struct EpiFfnIn : EpiBase {
    bf16_t* act;
    __device__ __forceinline__ bool operator()(EPI_ARGS) const {
#pragma unroll
        for (int ai = 0; ai < 2; ++ai)
#pragma unroll
            for (int m = 0; m < 4; ++m) {
                const size_t row = (size_t)u.pm * 256 + ROWLOC(ai, m);
                f32x4 o0, o1;
#pragma unroll
                for (int e = 0; e < 4; ++e) { o0[e] = fsilu(acc[ai][0][m][0][e]) * acc[ai][1][m][0][e]; o1[e] = fsilu(acc[ai][0][m][1][e]) * acc[ai][1][m][1][e]; }
                *(u32x4*)(act + row * DFF + u.pn * 128 + 32 * wc + 8 * fq) = pack8(o0, o1);
            }
        return false;
    }
};
template <bool RES_BF16> struct EpiResid : EpiBase {
    const float* res_f32; bf16_t* hbuf; float* dst_ctx; const float* mods; int gidx; float coef;
    __device__ __forceinline__ bool operator()(EPI_ARGS) const {
        const int ms = u.pm < 64 ? 0 : (u.pm < 128 ? 1 : 2);
        const float* g = mods + ms * (NMOD * D) + gidx * D;
#pragma unroll
        for (int bj = 0; bj < 2; ++bj) {
            const int col = u.pn * 256 + COLLOC(bj);
            const f32x4 g0 = *(const f32x4*)(g + col) * coef, g1 = *(const f32x4*)(g + col + 4) * coef;
            if (u.kind == 1) {
                float* dst = dst_ctx + (size_t)(u.pm - 128) * 256 * D;
#pragma unroll
                for (int ai = 0; ai < 2; ++ai)
#pragma unroll
                    for (int m = 0; m < 4; ++m) {
                        float* sl = dst + (size_t)u.w * (TC * D) + (size_t)ROWLOC(ai, m) * D + col;
                        *(f32x4*)sl = g0 * acc[ai][bj][m][0]; *(f32x4*)(sl + 4) = g1 * acc[ai][bj][m][1];
                    }
            } else {
                bf16_t* hp = hbuf + (size_t)u.pm * 256 * D;
#pragma unroll
                for (int ai = 0; ai < 2; ++ai) {
                    f32x4 r0[4], r1[4];
#pragma unroll
                    for (int m = 0; m < 4; ++m) { const size_t o = (size_t)ROWLOC(ai, m) * D + col;
                        if (RES_BF16) unpack8(*(const u32x4*)(hp + o), r0[m], r1[m]);
                        else { const float* rp = res_f32 + (size_t)u.pm * 256 * D + o; r0[m] = *(const f32x4*)rp; r1[m] = *(const f32x4*)(rp + 4); } }
#pragma unroll
                    for (int m = 0; m < 4; ++m) { const size_t o = (size_t)ROWLOC(ai, m) * D + col;
                        *(u32x4*)(hp + o) = pack8(r0[m] + g0 * acc[ai][bj][m][0], r1[m] + g1 * acc[ai][bj][m][1]); }
                }
            }
        }
        return false;
    }
};
constexpr float ROPE_C = 0.20762050593046014f;
constexpr float INV2PI = 0.15915494309189535f;
struct EpiProjT : EpiBase {
    bf16_t* ktf; bf16_t* ktb; bf16_t* vt; const float* dec; int ld, clen, rope;
    __device__ __forceinline__ bool operator()(EPI_ARGS) const {
        const int l0 = rope ? u.pn * 256 : 0;
        bf16_t* ktf = this->ktf; bf16_t* ktb = this->ktb; bf16_t* vt = this->vt;
        if (!rope) { const size_t bo = (size_t)u.pn * (CTX_STRIDE / 2); ktf += bo; ktb += bo; vt += bo; }
        if (u.pm >= 4) {
#pragma unroll
            for (int ai = 0; ai < 2; ++ai)
#pragma unroll
                for (int m = 0; m < 4; ++m) {
                    const int r = (u.pm - 4) * 256 + ROWLOC(ai, m);
                    const size_t rb = rope ? ((size_t)((r >> 9) * NCH + (u.pn >> 1)) * 512 + (r & 511)) * 512 + (u.pn & 1) * 256 : (size_t)r * ld + l0;
#pragma unroll
                    for (int bj = 0; bj < 2; ++bj) *(u32x4*)(vt + rb + COLLOC(bj)) = pack8(acc[ai][bj][m][0], acc[ai][bj][m][1]);
                }
        } else {
            const int h = u.pm; const float lgf = dec[h], lgb = dec[4 + h];
#pragma unroll
            for (int bj = 0; bj < 2; ++bj) {
                const int lb = l0 + COLLOC(bj);
#pragma unroll
                for (int m = 0; m < 4; ++m) {
                    const float invrev = ex2(-(float)(16 * m + fr) * ROPE_C) * INV2PI;
                    f32x4 f1[2], f2[2], b1[2], b2[2];
#pragma unroll
                    for (int n = 0; n < 2; ++n)
#pragma unroll
                        for (int e = 0; e < 4; ++e) {
                            const int l = lb + 4 * n + e, s = l & (clen - 1);
                            const float df = 0.0625f * ex2((float)(clen - 1 - s) * lgf), db = 0.0625f * ex2((float)s * lgb);
                            const float x1 = acc[0][bj][m][n][e], x2 = acc[1][bj][m][n][e];
                            float o1 = x1, o2 = x2;
                            if (rope) { const float rev = (float)(wr ? (l & 63) : (l >> 6)) * invrev; const float cs = __builtin_amdgcn_cosf(rev), sn = __builtin_amdgcn_sinf(rev); o1 = x1 * cs - x2 * sn; o2 = x1 * sn + x2 * cs; }
                            f1[n][e] = o1 * df; f2[n][e] = o2 * df; b1[n][e] = o1 * db; b2[n][e] = o2 * db;
                        }
                    const int cp = 64 * wr + 16 * m + fr;
                    const size_t r1 = rope ? ((size_t)(h * NCH + (u.pn >> 1)) * 256 + cp) * 512 + (u.pn & 1) * 256 + COLLOC(bj) : (size_t)(h * 256 + cp) * ld + lb;
                    const size_t r2 = r1 + (size_t)128 * (rope ? 512 : ld);
                    *(u32x4*)(ktf + r1) = pack8(f1[0], f1[1]); *(u32x4*)(ktf + r2) = pack8(f2[0], f2[1]);
                    *(u32x4*)(ktb + r1) = pack8(b1[0], b1[1]); *(u32x4*)(ktb + r2) = pack8(b2[0], b2[1]);
                }
            }
        }
        return false;
    }
};
struct EpiU : EpiBase {
    bf16_t* sb; float* rfb; int ctx;
    __device__ __forceinline__ bool operator()(EPI_ARGS) const {
        const int h = u.z, n = u.pn, dir = u.kind;
#pragma unroll
        for (int ai = 0; ai < 2; ++ai)
#pragma unroll
            for (int m = 0; m < 4; ++m) {
                const int dv = u.pm * 256 + ROWLOC(ai, m);
#pragma unroll
                for (int bj = 0; bj < 2; ++bj) {
                    const int dk = COLLOC(bj);
                    if (!ctx) *(u32x4*)(sb + ((size_t)((h * NCH + n) * 512 + dv)) * 512 + dir * 256 + dk) = pack8(acc[ai][bj][m][0], acc[ai][bj][m][1]);
                    else { float* p = rfb + (size_t)u.w * (CTX_STRIDE / 4) + ((size_t)((h * 2 + dir) * 512 + dv)) * 256 + dk; *(f32x4*)p = acc[ai][bj][m][0]; *(f32x4*)(p + 4) = acc[ai][bj][m][1]; }
                }
            }
        return false;
    }
};
struct EpiQK : EpiBase {
    bf16_t* q; bf16_t* k;
    __device__ __forceinline__ bool operator()(EPI_ARGS) const {
        const int isk = u.pn >= 4, h = u.pn & 3; bf16_t* dst = isk ? k : q; const float sc = isk ? 0.0625f : 1.0f;
        float invrev[8];
#pragma unroll
        for (int e = 0; e < 8; ++e) invrev[e] = ex2(-(float)((32 * wc + 8 * fq + e) & 63) * ROPE_C) * INV2PI;
#pragma unroll
        for (int ai = 0; ai < 2; ++ai)
#pragma unroll
            for (int m = 0; m < 4; ++m) {
                const int l = u.pm * 256 + ROWLOC(ai, m);
                const float pos = (float)(wc >= 2 ? (l & 63) : (l >> 6));
                f32x4 o1[2], o2[2];
#pragma unroll
                for (int n = 0; n < 2; ++n)
#pragma unroll
                    for (int e = 0; e < 4; ++e) {
                        const float x1 = acc[ai][0][m][n][e], x2 = acc[ai][1][m][n][e];
                        const float rev = pos * invrev[4 * n + e]; const float cs = __builtin_amdgcn_cosf(rev) * sc, sn = __builtin_amdgcn_sinf(rev) * sc;
                        o1[n][e] = x1 * cs - x2 * sn; o2[n][e] = x1 * sn + x2 * cs;
                    }
                bf16_t* p = dst + (size_t)l * D + h * 256 + 32 * wc + 8 * fq;
                *(u32x4*)p = pack8(o1[0], o1[1]); *(u32x4*)(p + 128) = pack8(o2[0], o2[1]);
            }
        return false;
    }
};
struct EpiP : EpiBase {
    bf16_t* pscr; const float* dec;
    __device__ __forceinline__ bool operator()(EPI_ARGS) const {
        const int h = u.z; const float lgf = dec[h], lgb = dec[4 + h];
#pragma unroll
        for (int ai = 0; ai < 2; ++ai)
#pragma unroll
            for (int m = 0; m < 4; ++m) {
                const int il = ROWLOC(ai, m), i = u.pm * 256 + il;
#pragma unroll
                for (int bj = 0; bj < 2; ++bj) {
                    const int j0 = u.w * 256 + COLLOC(bj);
                    f32x4 p[2];
#pragma unroll
                    for (int n = 0; n < 2; ++n)
#pragma unroll
                        for (int e = 0; e < 4; ++e) { const int d = i - (j0 + 4 * n + e); const float w = ex2(d >= 0 ? (float)d * lgf : (float)(-d) * lgb); p[n][e] = acc[ai][bj][m][n][e] * w; }
                    *(u32x4*)(pscr + (size_t)il * D + j0) = pack8(p[0], p[1]);
                }
            }
        return false;
    }
};
struct EpiSV : EpiBase {
    bf16_t* o; const float* dec;
    __device__ __forceinline__ bool operator()(EPI_ARGS) const {
        const int h = u.z; const float lgf = dec[h], lgb = dec[4 + h];
        const float c1 = u.kind == 1 ? lgf : 0.f, c2 = u.kind == 1 ? -lgb : (u.kind == 2 ? lgb : 0.f);
#pragma unroll
        for (int ai = 0; ai < 2; ++ai)
#pragma unroll
            for (int m = 0; m < 4; ++m) {
                const int i = u.pm * 256 + ROWLOC(ai, m);
                const float s = ex2((float)(i + 1) * c1 + (float)(CH - i) * c2);
#pragma unroll
                for (int bj = 0; bj < 2; ++bj)
#pragma unroll
                    for (int n = 0; n < 2; ++n)
#pragma unroll
                        for (int e = 0; e < 4; ++e) asm("s_nop 0\n\tv_mul_f32 %0, %0, %1" : "+v"(acc[ai][bj][m][n][e]) : "v"(s));
            }
        if (u.kind == 3) {
#pragma unroll
            for (int ai = 0; ai < 2; ++ai)
#pragma unroll
                for (int m = 0; m < 4; ++m) {
                    const size_t row = (size_t)u.pn * CH + u.pm * 256 + ROWLOC(ai, m);
#pragma unroll
                    for (int bj = 0; bj < 2; ++bj) *(u32x4*)(o + row * 2048 + h * 512 + u.w * 256 + COLLOC(bj)) = pack8(acc[ai][bj][m][0], acc[ai][bj][m][1]);
                }
        }
        return u.kind != 3;
    }
};
struct EpiRg : EpiBase {
    bf16_t* o; const float* stats; const float* gnw;
    __device__ __forceinline__ bool operator()(EPI_ARGS) const {
            const int head = u.pn >> 1;
#pragma unroll
            for (int bj = 0; bj < 2; ++bj) {
                const int col = u.pn * 256 + COLLOC(bj);
                const f32x4 w0 = *(const f32x4*)(gnw + col), w1 = *(const f32x4*)(gnw + col + 4);
#pragma unroll
                for (int ai = 0; ai < 2; ++ai) {
#pragma unroll
                    for (int mh = 0; mh < 4; mh += 2) {
                    f32x2 st[2]; u32x4 raw[2];
#pragma unroll
                    for (int m2 = 0; m2 < 2; ++m2) { const size_t row = (size_t)u.pm * 256 + ROWLOC(ai, mh + m2); st[m2] = *(const f32x2*)(stats + (row * 4 + head) * 2); raw[m2] = *(const u32x4*)(o + row * 2048 + col); }
#pragma unroll
                    for (int m2 = 0; m2 < 2; ++m2) {
                        const int m = mh + m2;
                        const size_t row = (size_t)u.pm * 256 + ROWLOC(ai, m);
                        f32x4 v0, v1; unpack8(raw[m2], v0, v1);
                        f32x4 r0, r1;
#pragma unroll
                        for (int e = 0; e < 4; ++e) { r0[e] = fsilu(acc[ai][bj][m][0][e]) * ((v0[e] - st[m2].x) * st[m2].y * w0[e]); r1[e] = fsilu(acc[ai][bj][m][1][e]) * ((v1[e] - st[m2].x) * st[m2].y * w1[e]); }
                        *(u32x4*)(o + row * 2048 + col) = pack8(r0, r1);
                    }
                    asm volatile("" ::: "memory");
                    }
                    asm volatile("" ::: "memory");
                }
            }
        return false;
    }
};
struct EpiCv : EpiBase {
    bf16_t* y;
    __device__ __forceinline__ bool operator()(EPI_ARGS) const {
            const int pt = u.pn;
#pragma unroll
            for (int ai = 0; ai < 2; ++ai)
#pragma unroll
                for (int m = 0; m < 4; ++m) {
                    const size_t row = (size_t)u.pm * 256 + ROWLOC(ai, m);
                    f32x4 o0, o1;
#pragma unroll
                    for (int e = 0; e < 4; ++e) { o0[e] = acc[ai][0][m][0][e] * fsig(acc[ai][1][m][0][e]); o1[e] = acc[ai][0][m][1][e] * fsig(acc[ai][1][m][1][e]); }
                    *(u32x4*)(y + row * D + pt * 128 + 32 * wc + 8 * fq) = pack8(o0, o1);
                }
        return false;
    }
};
struct EpiBf16 : EpiBase {
    bf16_t* dst; int ld;
    __device__ __forceinline__ bool operator()(EPI_ARGS) const {
#pragma unroll
        for (int ai = 0; ai < 2; ++ai)
#pragma unroll
            for (int m = 0; m < 4; ++m) {
                const size_t row = (size_t)u.pm * 256 + ROWLOC(ai, m);
#pragma unroll
                for (int bj = 0; bj < 2; ++bj) *(u32x4*)(dst + row * ld + u.pn * 256 + COLLOC(bj)) = pack8(acc[ai][bj][m][0], acc[ai][bj][m][1]);
            }
        return false;
    }
};
struct EpiGab : EpiBase {
    bf16_t* yr; const bf16_t* yc;
    __device__ __forceinline__ bool operator()(EPI_ARGS) const {
#pragma unroll
        for (int ai = 0; ai < 2; ++ai) {
            u32x4 ra[4], rc[4];
#pragma unroll
            for (int m = 0; m < 4; ++m) { const size_t off = ((size_t)u.pm * 256 + ROWLOC(ai, m)) * D + u.pn * 128 + 32 * wc + 8 * fq; ra[m] = *(const u32x4*)(yr + off); rc[m] = *(const u32x4*)(yc + off); }
#pragma unroll
            for (int m = 0; m < 4; ++m) {
                const size_t off = ((size_t)u.pm * 256 + ROWLOC(ai, m)) * D + u.pn * 128 + 32 * wc + 8 * fq;
                f32x4 a0, a1, c0, c1; unpack8(ra[m], a0, a1); unpack8(rc[m], c0, c1);
                f32x4 o0, o1;
#pragma unroll
                for (int e = 0; e < 4; ++e) { o0[e] = fsig(acc[ai][0][m][0][e]) * a0[e] + fsig(acc[ai][1][m][0][e]) * c0[e]; o1[e] = fsig(acc[ai][0][m][1][e]) * a1[e] + fsig(acc[ai][1][m][1][e]) * c1[e]; }
                *(u32x4*)(yr + off) = pack8(o0, o1);
            }
            asm volatile("" ::: "memory");
        }
        return false;
    }
};

__device__ __forceinline__ int rowmap_win(int n) {
    if (n < 2048) { const int d = n & 255; const int c = d < 64 ? d : (d < 128 ? d + 64 : (d < 192 ? d - 64 : d)); return (n & ~255) + c; }
    if (n < 6144) return n;
    if (n < 8192) { int j = n - 6144; const int g = j >> 10; j &= 1023; return 6144 + 256 * (j >> 7) + 128 * g + (j & 127); }
    { int j = n - 8192; const int g = j >> 10; j &= 1023; return 8192 + 256 * (j >> 7) + 128 * g + (j & 127); }
}
__device__ __forceinline__ int rowmap_ffn(int n) { if (n < DFF) return 256 * (n >> 7) + (n & 127); const int j = n - DFF; return 256 * (j >> 7) + 128 + (j & 127); }
__device__ __forceinline__ void transpose_item(const float* W, int K, int N, bf16_t* WT, int mapk, LAS float* scr, int item, int lane) {
    const int nblk = N / 32, kb = item / nblk, nb = item % nblk, k0 = 64 * kb, n0 = 32 * nb;
#pragma unroll 8
    for (int i = 0; i < 32; ++i) { const int kk = 2 * i + (lane >> 5); scr[kk * 33 + (lane & 31)] = __builtin_nontemporal_load(&W[(size_t)(k0 + kk) * N + n0 + (lane & 31)]); }
    asm volatile("s_waitcnt lgkmcnt(0)" ::: "memory");
    const int c = lane & 7;
#pragma unroll
    for (int j = 0; j < 4; ++j) { const int n = (lane >> 3) + 8 * j; const LAS float* s = scr + (8 * c) * 33 + n;
        u32x4 o; o.x = pk2(s[0 * 33], s[1 * 33]); o.y = pk2(s[2 * 33], s[3 * 33]); o.z = pk2(s[4 * 33], s[5 * 33]); o.w = pk2(s[6 * 33], s[7 * 33]);
        const int nn = n0 + n; const int row = mapk == 0 ? nn : (mapk == 1 ? rowmap_ffn(nn) : rowmap_win(nn));
        *(u32x4*)(WT + (size_t)row * K + k0 + 8 * c) = o; }
    asm volatile("s_waitcnt lgkmcnt(0)" ::: "memory");
}
__device__ __forceinline__ void norm_rows(const float* src, bf16_t* dst, int nrows, const f32x4 (&wv)[4], const f32x4 (&shv)[4], int gw, int ngw, int lane) {
    for (int row0 = gw * 2; row0 < nrows; row0 += ngw * 2) {
        f32x4 v[2][4]; float ss[2];
#pragma unroll
        for (int rr = 0; rr < 2; ++rr) { const float* s = src + (size_t)(row0 + rr) * D + 4 * lane;
#pragma unroll
            for (int j = 0; j < 4; ++j) v[rr][j] = *(const f32x4*)(s + 256 * j); }
#pragma unroll
        for (int rr = 0; rr < 2; ++rr) { float a = 0.f;
#pragma unroll
            for (int j = 0; j < 4; ++j) a += (v[rr][j][0] * v[rr][j][0] + v[rr][j][1] * v[rr][j][1]) + (v[rr][j][2] * v[rr][j][2] + v[rr][j][3] * v[rr][j][3]);
            ss[rr] = a; }
#pragma unroll
        for (int rr = 0; rr < 2; ++rr) {
            const float r = rsqrtf(wave_sum(ss[rr], lane) * (1.0f / D) + EPS);
            bf16_t* d = dst + (size_t)(row0 + rr) * D + 4 * lane;
#pragma unroll
            for (int j = 0; j < 4; ++j) { const f32x4 y = v[rr][j] * r * wv[j] + shv[j]; u32x2 o; o.x = pk2(y[0], y[1]); o.y = pk2(y[2], y[3]); *(u32x2*)(d + 256 * j) = o; }
        }
    }
}
__device__ __forceinline__ void load_mod8(const float* normw, const float* mods, int ms, int shidx, int lane, f32x4 (&wv)[4], f32x4 (&shv)[4]) {
#pragma unroll
    for (int j = 0; j < 2; ++j)
#pragma unroll
        for (int q = 0; q < 2; ++q) { const int c = 8 * lane + 512 * j + 4 * q;
            const f32x4 w = *(const f32x4*)(normw + c), sc = *(const f32x4*)(mods + ms * (NMOD * D) + (shidx + 1) * D + c);
            shv[2 * j + q] = *(const f32x4*)(mods + ms * (NMOD * D) + shidx * D + c); wv[2 * j + q] = w * (sc + 1.0f); }
}
__device__ __forceinline__ void norm_rows_h(const bf16_t* src, bf16_t* dst, int nrows, const f32x4 (&wv)[4], const f32x4 (&shv)[4], int gw, int ngw, int lane) {
    for (int row0 = gw * 2; row0 < nrows; row0 += ngw * 2) {
        u32x4 raw[2][2]; f32x4 v[2][4]; float ss[2];
#pragma unroll
        for (int rr = 0; rr < 2; ++rr)
#pragma unroll
            for (int j = 0; j < 2; ++j) raw[rr][j] = *(const u32x4*)(src + (size_t)(row0 + rr) * D + 8 * lane + 512 * j);
#pragma unroll
        for (int rr = 0; rr < 2; ++rr) { float a = 0.f;
#pragma unroll
            for (int j = 0; j < 2; ++j) unpack8(raw[rr][j], v[rr][2 * j], v[rr][2 * j + 1]);
#pragma unroll
            for (int q = 0; q < 4; ++q) a += (v[rr][q][0] * v[rr][q][0] + v[rr][q][1] * v[rr][q][1]) + (v[rr][q][2] * v[rr][q][2] + v[rr][q][3] * v[rr][q][3]);
            ss[rr] = a; }
#pragma unroll
        for (int rr = 0; rr < 2; ++rr) {
            const float r = rsqrtf(wave_sum(ss[rr], lane) * (1.0f / D) + EPS);
#pragma unroll
            for (int j = 0; j < 2; ++j) *(u32x4*)(dst + (size_t)(row0 + rr) * D + 8 * lane + 512 * j) = pack8(v[rr][2 * j] * r * wv[2 * j] + shv[2 * j], v[rr][2 * j + 1] * r * wv[2 * j + 1] + shv[2 * j + 1]);
        }
    }
}
__device__ __forceinline__ void norm_rows_ctx(const float* cx, const float* slab, bf16_t* dst, int nrows, const f32x4 (&wv)[4], const f32x4 (&shv)[4], int gw, int ngw, int lane) {
    for (int row = gw; row < nrows; row += ngw) {
        const size_t ro = (size_t)row * D + 4 * lane;
        f32x4 v[4]; float ss = 0.f;
#pragma unroll
        for (int j = 0; j < 4; ++j) { f32x4 a = *(const f32x4*)(cx + ro + 256 * j);
#pragma unroll
            for (int k = 0; k < 11; ++k) a += *(const f32x4*)(slab + (size_t)k * (TC * D) + ro + 256 * j);
            v[j] = a; ss += (a[0] * a[0] + a[1] * a[1]) + (a[2] * a[2] + a[3] * a[3]); }
        const float r = rsqrtf(wave_sum(ss, lane) * (1.0f / D) + EPS);
        bf16_t* d = dst + ro;
#pragma unroll
        for (int j = 0; j < 4; ++j) { const f32x4 y = v[j] * r * wv[j] + shv[j]; u32x2 o; o.x = pk2(y[0], y[1]); o.y = pk2(y[2], y[3]); *(u32x2*)(d + 256 * j) = o; }
    }
}
__device__ __forceinline__ void load_mod(const float* normw, const float* mods, int ms, int shidx, int lane, f32x4 (&wv)[4], f32x4 (&shv)[4]) {
#pragma unroll
    for (int j = 0; j < 4; ++j) { const int c = 4 * lane + 256 * j;
        const f32x4 w = *(const f32x4*)(normw + c), sc = *(const f32x4*)(mods + ms * (NMOD * D) + (shidx + 1) * D + c);
        shv[j] = *(const f32x4*)(mods + ms * (NMOD * D) + shidx * D + c); wv[j] = w * (sc + 1.0f); }
}

struct Params { const float* in[25]; float* out; unsigned char* ws; };

typedef const __attribute__((address_space(4))) Params* KParams;
#define PHASE_BEGIN \
    KParams pp = (KParams)__builtin_amdgcn_kernarg_segment_ptr(); asm volatile("" : "+s"(pp)); \
    unsigned char* ws = pp->ws; \
    int tid = threadIdx.x; asm volatile("" : "+v"(tid)); \
    const int lane = tid & 63, wid = __builtin_amdgcn_readfirstlane(tid >> 6), G = gridDim.x, bid = blockIdx.x, gw = bid * 8 + wid, ngw = G * 8; \
    const int vcu = (G % 8 == 0) ? (bid % 8) * (G / 8) + bid / 8 : bid;      \
    (void)lane; (void)wid; (void)gw; (void)ngw; (void)ws; (void)vcu;
constexpr int LDS_BAR_OFF = 140 * 1024;
#define GSYNC() do { KParams _p = (KParams)__builtin_amdgcn_kernarg_segment_ptr(); asm volatile("" : "+s"(_p)); \
    XcdBarrier _b; _b.bar = (unsigned*)(_p->ws + WS_BAR); _b.x = xb_xcc_id(); _b.st = (volatile LAS unsigned*)(lds + LDS_BAR_OFF); xcd_barrier(_b); } while (0)
#define GSYNC_CG() do { asm volatile("s_waitcnt vmcnt(0)" ::: "memory"); grid.sync(); \
    if (threadIdx.x == 0) { __builtin_amdgcn_fence(__ATOMIC_ACQUIRE, "agent"); asm volatile("s_waitcnt vmcnt(0)" ::: "memory"); } __syncthreads(); } while (0)
#define IN(i) (pp->in[i])
#define WSP(T_, off) ((T_*)(ws + (off)))

#define R0_PHASE() do { \
        { \
            PHASE_BEGIN \
            const float* mods = WSP(float, WS_MODS); bf16_t* xn = WSP(bf16_t, WS_XN); const bf16_t* hb = WSP(bf16_t, WS_H); \
            f32x4 wv[4], shv[4]; \
            load_mod8(IN(9), mods, 0, 3, lane, wv, shv); norm_rows_h(hb, xn, L, wv, shv, gw, ngw, lane); \
            load_mod8(IN(9), mods, 1, 3, lane, wv, shv); norm_rows_h(hb + (size_t)L * D, xn + (size_t)L * D, L, wv, shv, gw, ngw, lane); \
            load_mod(IN(9), mods, 2, 3, lane, wv, shv); norm_rows_ctx(IN(2), WSP(float, WS_SLAB), xn + (size_t)T * D, TC, wv, shv, gw, ngw, lane); \
        } \
    } while (0)

__global__ void __launch_bounds__(512, 2) fwd_megakernel(Params Parg) {
    extern __shared__ __attribute__((aligned(16))) unsigned char shm[];
    LAS unsigned char* lds = (LAS unsigned char*)shm;
    cg::grid_group grid = cg::this_grid();
    if (threadIdx.x < 4) ((volatile LAS unsigned*)(lds + LDS_BAR_OFF))[threadIdx.x] = 0u;
    __syncthreads();
    { KParams _p = (KParams)__builtin_amdgcn_kernarg_segment_ptr(); if (threadIdx.x == 0) (void)xb_add(&((unsigned*)(_p->ws + WS_BAR))[XB_XCNT(xb_xcc_id())], 1u); }

    {
        PHASE_BEGIN
        LAS float* scr = (LAS float*)(lds + wid * 8448);
        const float* w_mod = IN(4); const float* cvec = IN(1); const float* cctx = IN(3); float* part = WSP(float, WS_PART);
        constexpr int I_FI = 16 * (2 * DFF / 32), I_FO = (DFF / 64) * 32, I_IN = 16 * (INW / 32), I_RET = 32 * 32, I_SQ = 16 * 32;
        constexpr int NCONV = 2 * I_FI + 2 * I_FO + I_IN + I_RET + 2 * I_SQ, NMODI = 8 * 144;
        for (int it = gw; it < NCONV + NMODI; it += ngw) {
            int r = it;
            if (r >= NCONV) {
                r -= NCONV; const int kc = r / 144, nc = r % 144, n = nc * 64 + lane;
                float a0 = 0.f, a1 = 0.f, a2 = 0.f;
                for (int k = kc * 128; k < kc * 128 + 128; ++k) { const float w = __builtin_nontemporal_load(&w_mod[(size_t)k * (NMOD * D) + n]); a0 += fsilu(cvec[k]) * w; a1 += fsilu(cvec[D + k]) * w; a2 += fsilu(cctx[k]) * w; }
                part[(kc * 3 + 0) * (NMOD * D) + n] = a0; part[(kc * 3 + 1) * (NMOD * D) + n] = a1; part[(kc * 3 + 2) * (NMOD * D) + n] = a2;
                continue;
            }
            if (r < I_FI) { transpose_item(IN(7), D, 2 * DFF, WSP(bf16_t, WS_WFFN1IN), 1, scr, r, lane); continue; } r -= I_FI;
            if (r < I_FI) { transpose_item(IN(22), D, 2 * DFF, WSP(bf16_t, WS_WFFN2IN), 1, scr, r, lane); continue; } r -= I_FI;
            if (r < I_FO) { transpose_item(IN(8), DFF, D, WSP(bf16_t, WS_WFFN1OUT), 0, scr, r, lane); continue; } r -= I_FO;
            if (r < I_FO) { transpose_item(IN(23), DFF, D, WSP(bf16_t, WS_WFFN2OUT), 0, scr, r, lane); continue; } r -= I_FO;
            if (r < I_IN) { transpose_item(IN(10), D, INW, WSP(bf16_t, WS_WIN), 2, scr, r, lane); continue; } r -= I_IN;
            if (r < I_RET) { transpose_item(IN(14), 2048, D, WSP(bf16_t, WS_WRET), 0, scr, r, lane); continue; } r -= I_RET;
            if (r < I_SQ) { transpose_item(IN(19), D, D, WSP(bf16_t, WS_WCONV), 0, scr, r, lane); continue; } r -= I_SQ;
            transpose_item(IN(20), D, D, WSP(bf16_t, WS_WOUT), 0, scr, r, lane);
        }
        if (bid == 0 && tid < 8) { const float xl = tid < 4 ? IN(11)[tid] : IN(12)[tid - 4]; WSP(float, WS_DEC)[tid] = -log1pf(expf(-xl)) * 1.4426950408889634f; }
    }
    if (gridDim.x > 1024u) GSYNC_CG();
    GSYNC();
    {
        PHASE_BEGIN
        const float* x = IN(0); bf16_t* xn = WSP(bf16_t, WS_XN);
        const float* b_mod = IN(5); const float* part = WSP(float, WS_PART); float* mods = WSP(float, WS_MODS);
        for (int i = bid * 512 + tid; i < 3 * NMOD * D; i += G * 512) {
            const int ms = i / (NMOD * D), n = i % (NMOD * D); float a = b_mod[n];
#pragma unroll
            for (int p = 0; p < 8; ++p) a += part[(p * 3 + ms) * (NMOD * D) + n];
            mods[i] = a;
        }
        f32x4 wv[4], shv[4];
#pragma unroll 1
        for (int ms = 0; ms < 3; ++ms) {
#pragma unroll
            for (int j = 0; j < 4; ++j) { const int c = 4 * lane + 256 * j;
                f32x4 sh = *(const f32x4*)(b_mod + c), sc = *(const f32x4*)(b_mod + D + c);
#pragma unroll
                for (int p = 0; p < 8; ++p) { sh += *(const f32x4*)(part + (p * 3 + ms) * (NMOD * D) + c); sc += *(const f32x4*)(part + (p * 3 + ms) * (NMOD * D) + D + c); }
                shv[j] = sh; wv[j] = *(const f32x4*)(IN(6) + c) * (sc + 1.0f); }
            if (ms < 2) norm_rows(x + (size_t)ms * L * D, xn + (size_t)ms * L * D, L, wv, shv, gw, ngw, lane);
            else norm_rows(IN(2), xn + (size_t)T * D, TC, wv, shv, gw, ngw, lane);
        }
    }
    GSYNC();
    { PHASE_BEGIN
      GridSched S{(const char*)(ws + WS_XN), (const char*)(ws + WS_WFFN1IN), D * 2, D * 2, 16, MALL / 256, 2 * DFF / 256, G, bid}; EpiFfnIn E; E.act = WSP(bf16_t, WS_ACT); gemm_phase(lds, S, E); }
    GSYNC();
    { PHASE_BEGIN
      Ffn1OutSched S{(const char*)(ws + WS_ACT), (const char*)(ws + WS_WFFN1OUT), G, bid};
      EpiResid<false> E; E.res_f32 = IN(0); E.hbuf = WSP(bf16_t, WS_H); E.dst_ctx = WSP(float, WS_SLAB); E.mods = WSP(float, WS_MODS); E.gidx = 2; E.coef = 0.5f; gemm_phase(lds, S, E); }
    GSYNC();
    for (int b = 0; b < NB; ++b) {
        if (b == 0) { R0_PHASE(); GSYNC(); }
        { PHASE_BEGIN
          GridSched S{(const char*)(ws + WS_WIN + (size_t)1024 * D * 2), (const char*)(ws + WS_XN + (size_t)b * L * D * 2), D * 2, D * 2, 16, 12, L / 256, G, bid};
          EpiProjT E; E.ktf = WSP(bf16_t, WS_KTQK); E.ktb = WSP(bf16_t, WS_KTQK + 32 * MiB); E.vt = WSP(bf16_t, WS_VT); E.dec = WSP(float, WS_DEC); E.ld = L; E.clen = CH; E.rope = 1; gemm_phase(lds, S, E); }
        if (b == 0) { PHASE_BEGIN
          GridSched S{(const char*)(ws + WS_WIN + (size_t)1024 * D * 2), (const char*)(ws + WS_XN + (size_t)T * D * 2), D * 2, D * 2, 16, 12, 2, G, (bid + 128) % G};
          EpiProjT E; E.ktf = WSP(bf16_t, WS_CTX + CTX_KT); E.ktb = WSP(bf16_t, WS_CTX + CTX_KT + 512 * 1024); E.vt = WSP(bf16_t, WS_CTX + CTX_VT); E.dec = WSP(float, WS_DEC); E.ld = CTXL; E.clen = CTXL; E.rope = 0; gemm_phase(lds, S, E); }
        GSYNC();
        { PHASE_BEGIN
          USched S{(const char*)(ws + WS_VT), (const char*)(ws + WS_KTQK), (const char*)(ws + WS_KTQK + 32 * MiB), G, vcu}; EpiU E; E.sb = WSP(bf16_t, WS_SB); E.rfb = WSP(float, WS_CTX); E.ctx = 0; gemm_phase(lds, S, E); }
        if (b == 0) { PHASE_BEGIN
          UCtxSched S{(const char*)(ws + WS_CTX + CTX_VT), (const char*)(ws + WS_CTX + CTX_KT), (const char*)(ws + WS_CTX + CTX_KT + 512 * 1024), G, (bid + 64) % G}; EpiU E; E.sb = WSP(bf16_t, WS_SB); E.rfb = WSP(float, WS_CTX); E.ctx = 1; gemm_phase(lds, S, E); }
        GSYNC();
        {
            PHASE_BEGIN
            bf16_t* sb = WSP(bf16_t, WS_SB); const float* rfb = WSP(float, WS_CTX + (size_t)b * CTX_STRIDE); const float* dec = WSP(float, WS_DEC);
            for (int it = bid * 512 + tid; it < 4 * 512 * 2 * 32; it += G * 512) {
                const int dg = it & 31, dir = (it >> 5) & 1, e = (it >> 6) & 511, h = it >> 15;
                const float cdec = ex2((float)CH * dec[dir * 4 + h]);
                bf16_t* base = sb + ((size_t)(h * NCH) * 512 + e) * 512 + dir * 256 + dg * 8;
                const float* r0 = rfb + ((size_t)((h * 2 + dir) * 512 + e)) * 256 + dg * 8;
                f32x4 c0 = *(const f32x4*)r0, c1 = *(const f32x4*)(r0 + 4);
#pragma unroll 1
                for (int g16 = 0; g16 < NCH / 16; ++g16) {
                    u32x4 ldv[16];
                    bf16_t* bp = base + (size_t)(dir ? (NCH - 1 - g16 * 16) : g16 * 16) * (512 * 512);
                    const ptrdiff_t st = dir ? -(ptrdiff_t)(512 * 512) : (ptrdiff_t)(512 * 512);
#pragma unroll
                    for (int j = 0; j < 16; ++j) ldv[j] = *(const u32x4*)(bp + j * st);
#pragma unroll
                    for (int j = 0; j < 16; ++j) { f32x4 t0, t1; unpack8(ldv[j], t0, t1); *(u32x4*)(bp + j * st) = pack8(c0, c1); c0 = c0 * cdec + t0; c1 = c1 * cdec + t1; }
                }
            }
        }
        { PHASE_BEGIN
          GridSched S{(const char*)(ws + WS_XN + (size_t)b * L * D * 2), (const char*)(ws + WS_WIN), D * 2, D * 2, 16, L / 256, 8, G, bid}; EpiQK E; E.q = WSP(bf16_t, WS_KTQK); E.k = WSP(bf16_t, WS_KTQK + 32 * MiB); gemm_phase(lds, S, E); }
        GSYNC();
        for (int it5 = 0; it5 * (int)gridDim.x < NCH * 4 * 2; ++it5) {
            const int g5 = gridDim.x, b5 = blockIdx.x, item = it5 * g5 + ((g5 % 8 == 0) ? (b5 % 8) * (g5 / 8) + b5 / 8 : b5);
            if (item >= NCH * 4 * 2) break;
            { PHASE_BEGIN
              bf16_t* pscr = (bf16_t*)(ws + WS_PSCR + (size_t)(bid >> 1) * (256 * D * 2) + (size_t)(bid & 1) * (CH * 2));
              QKSched S{(const char*)(ws + WS_KTQK), (const char*)(ws + WS_KTQK + 32 * MiB), item}; EpiP E; E.pscr = pscr; E.dec = WSP(float, WS_DEC); gemm_phase(lds, S, E); }
            __builtin_amdgcn_fence(__ATOMIC_ACQUIRE, "agent");
            { PHASE_BEGIN
              bf16_t* pscr = (bf16_t*)(ws + WS_PSCR + (size_t)(bid >> 1) * (256 * D * 2) + (size_t)(bid & 1) * (CH * 2));
              const int ib = item & 1, h = (item >> 1) & 3, n = item >> 3;
              SVSched S{(const char*)(ws + WS_KTQK) + ((size_t)(n * CH + ib * 256) * D + h * 256) * 2, (const char*)(ws + WS_SB) + ((size_t)((h * NCH + n) * 512) * 512) * 2,
                        (const char*)(ws + WS_VT) + ((size_t)((h * NCH + n) * 512) * 512) * 2, (const char*)pscr, item};
              EpiSV E; E.o = (bf16_t*)pp->out + (size_t)b * L * 2048; E.dec = WSP(float, WS_DEC); gemm_phase(lds, S, E); }
        }
        GSYNC();
    }
    {
        PHASE_BEGIN
        const float* mods = WSP(float, WS_MODS); bf16_t* xn = WSP(bf16_t, WS_XN); const bf16_t* hb = WSP(bf16_t, WS_H); const bf16_t* ob = (const bf16_t*)pp->out;
        (void)mods; (void)xn; (void)hb;
        float* stats = WSP(float, WS_STATS);
        for (int row0 = gw * 2; row0 < T; row0 += ngw * 2) {
            u32x4 raw[2][4];
#pragma unroll
            for (int rr = 0; rr < 2; ++rr)
#pragma unroll
                for (int h = 0; h < 4; ++h) raw[rr][h] = *(const u32x4*)(ob + (size_t)(row0 + rr) * 2048 + h * 512 + lane * 8);
            float sm[8], sq[8]; f32x4 vv[8][2];
#pragma unroll
            for (int i = 0; i < 8; ++i) { unpack8(raw[i >> 2][i & 3], vv[i][0], vv[i][1]); sm[i] = (vv[i][0][0] + vv[i][0][1]) + (vv[i][0][2] + vv[i][0][3]) + (vv[i][1][0] + vv[i][1][1]) + (vv[i][1][2] + vv[i][1][3]); }
            wave_sum_n<8>(sm, lane);
#pragma unroll
            for (int i = 0; i < 8; ++i) { const float mu = sm[i] * (1.0f / 512.0f); const f32x4 d0 = vv[i][0] - mu, d1 = vv[i][1] - mu; sm[i] = mu;
                sq[i] = (d0[0] * d0[0] + d0[1] * d0[1]) + (d0[2] * d0[2] + d0[3] * d0[3]) + (d1[0] * d1[0] + d1[1] * d1[1]) + (d1[2] * d1[2] + d1[3] * d1[3]); }
            wave_sum_n<8>(sq, lane);
            if (lane == 0) {
#pragma unroll
                for (int i = 0; i < 8; ++i) { f32x2 st; st.x = sm[i]; st.y = rsqrtf(sq[i] * (1.0f / 512.0f) + EPS); *(f32x2*)(stats + ((size_t)(row0 + (i >> 2)) * 4 + (i & 3)) * 2) = st; }
            }
        }
    }
    GSYNC();
    { PHASE_BEGIN
      GridSched S{(const char*)(ws + WS_XN), (const char*)(ws + WS_WIN + (size_t)4096 * D * 2), D * 2, D * 2, 16, T / 256, 8, G, bid};
      EpiRg E; E.o = (bf16_t*)pp->out; E.stats = WSP(float, WS_STATS); E.gnw = IN(13); gemm_phase(lds, S, E); }
    { PHASE_BEGIN
      GridSched S{(const char*)(ws + WS_XN), (const char*)(ws + WS_WIN + (size_t)6144 * D * 2), D * 2, D * 2, 16, T / 256, 8, G, bid};
      EpiCv E; E.y = WSP(bf16_t, WS_Y); gemm_phase(lds, S, E); }
    GSYNC();
    {
        PHASE_BEGIN
        const bf16_t* yb = WSP(bf16_t, WS_Y); bf16_t* zb = WSP(bf16_t, WS_Z);
        LAS unsigned* ytile = (LAS unsigned*)lds;
        LAS float* red = (LAS float*)(lds + 62 * 2048);
        const float* cw = IN(15);
        f32x2 w2v[31];
#pragma unroll
        for (int w = 0; w < 31; ++w) w2v[w] = *(const f32x2*)(cw + w * D + 2 * tid);
        const f32x2 cb = *(const f32x2*)(IN(16) + 2 * tid), lw = *(const f32x2*)(IN(17) + 2 * tid), lb = *(const f32x2*)(IN(18) + 2 * tid);
#define CONV_LOAD(TILE) do { const int _bt = (TILE) / (L / 32), _t0 = ((TILE) % (L / 32)) * 32; int tl = tid; asm volatile("" : "+v"(tl));     \
            _Pragma("unroll 1") for (int kb = 0; kb < 16; kb += 4) { u32x4 stg[4]; \
            _Pragma("unroll") for (int k = 0; k < 4; ++k) { const int idx = tl + (kb + k) * 512, r = idx >> 7, c16 = idx & 127, l = _t0 - 15 + r; \
                stg[k] = (u32x4){0u, 0u, 0u, 0u}; if (idx < 62 * 128 && l >= 0 && l < L) stg[k] = *(const u32x4*)(yb + ((size_t)_bt * L + l) * D + c16 * 8); } \
            _Pragma("unroll") for (int k = 0; k < 4; ++k) { const int idx = tl + (kb + k) * 512, r = idx >> 7, c16 = idx & 127; if (idx < 62 * 128) *(LAS u32x4*)(ytile + r * 512 + c16 * 4) = stg[k]; } } } while (0)
        for (int tile = bid; tile < T / 32; tile += G) {
            const int bt = tile / (L / 32), t0 = (tile % (L / 32)) * 32;
            __syncthreads();
            CONV_LOAD(tile);
            __syncthreads();
#pragma unroll 1
            for (int sbk = 0; sbk < 2; ++sbk) {
                f32x2 a2[16];
#pragma unroll
                for (int tt = 0; tt < 16; ++tt) a2[tt] = cb;
#pragma unroll
                for (int w2 = 0; w2 < 46; ++w2) {
                    const unsigned pv = ytile[(sbk * 16 + w2) * 512 + tid]; f32x2 v; v.x = bflo(pv); v.y = bfhi(pv);
#pragma unroll
                    for (int tt = 0; tt < 16; ++tt) { const int w = w2 - tt; if (w >= 0 && w < 31) a2[tt] = __builtin_elementwise_fma(v, w2v[w], a2[tt]); }
                }
                LAS float* rd = red + (sbk & 1) * 256;
                { float r16[16];
#pragma unroll
                  for (int tt = 0; tt < 16; ++tt) r16[tt] = a2[tt].x + a2[tt].y;
                  const float tot = wave_reduce16(r16, lane);
#pragma unroll
                  for (int tt = 0; tt < 16; ++tt) r16[tt] = a2[tt].x * a2[tt].x + a2[tt].y * a2[tt].y;
                  const float tot2 = wave_reduce16(r16, lane);
                  const int ri = ((lane >> 5) & 1) * 8 + ((lane >> 4) & 1) * 4 + ((lane >> 3) & 1) * 2 + ((lane >> 2) & 1);
                  if ((lane & 3) == 0) { rd[wid * 32 + ri] = tot; rd[wid * 32 + 16 + ri] = tot2; } }
                __syncthreads();
                f32x4 tsum[8];
#pragma unroll
                for (int q4 = 0; q4 < 8; ++q4) tsum[q4] = (f32x4){0.f, 0.f, 0.f, 0.f};
#pragma unroll
                for (int wv8 = 0; wv8 < 8; ++wv8)
#pragma unroll
                    for (int q4 = 0; q4 < 8; ++q4) tsum[q4] += *(const LAS f32x4*)(rd + wv8 * 32 + q4 * 4);
#pragma unroll
                for (int tt = 0; tt < 16; ++tt) {
                    const float t1 = tsum[tt >> 2][tt & 3], t2 = tsum[4 + (tt >> 2)][tt & 3];
                    const float mu = t1 * (1.0f / D), var = fmaxf(t2 * (1.0f / D) - mu * mu, 0.f), rs = rsqrtf(var + EPS);
                    const float z0 = fsilu((a2[tt].x - mu) * rs * lw.x + lb.x), z1 = fsilu((a2[tt].y - mu) * rs * lw.y + lb.y);
                    *(unsigned*)(zb + ((size_t)bt * L + t0 + sbk * 16 + tt) * D + 2 * tid) = pk2(z0, z1);
                }
            }
        }
        __syncthreads();
    }
    { PHASE_BEGIN
      GridSched S{(const char*)pp->out, (const char*)(ws + WS_WRET), 2048 * 2, 2048 * 2, 32, T / 256, 4, G, bid}; EpiBf16 E; E.dst = WSP(bf16_t, WS_YR); E.ld = D; gemm_phase(lds, S, E); }
    GSYNC();
    { PHASE_BEGIN
      GridSched S{(const char*)(ws + WS_Z), (const char*)(ws + WS_WCONV), D * 2, D * 2, 16, T / 256, 4, G, bid}; EpiBf16 E; E.dst = WSP(bf16_t, WS_YC); E.ld = D; gemm_phase(lds, S, E); }
    GSYNC();
    { PHASE_BEGIN
      GridSched S{(const char*)(ws + WS_XN), (const char*)(ws + WS_WIN + (size_t)8192 * D * 2), D * 2, D * 2, 16, T / 256, 8, G, bid}; EpiGab E; E.yr = WSP(bf16_t, WS_YR); E.yc = WSP(bf16_t, WS_YC); gemm_phase(lds, S, E); }
    GSYNC();
    { PHASE_BEGIN
      GridSched S{(const char*)(ws + WS_YR), (const char*)(ws + WS_WOUT), D * 2, D * 2, 16, T / 256, 4, G, bid};
      EpiResid<true> E; E.res_f32 = nullptr; E.hbuf = WSP(bf16_t, WS_H); E.dst_ctx = nullptr; E.mods = WSP(float, WS_MODS); E.gidx = 5; E.coef = 1.0f; gemm_phase(lds, S, E); }
    GSYNC();
    {
        PHASE_BEGIN
        const float* mods = WSP(float, WS_MODS); bf16_t* xn = WSP(bf16_t, WS_XN); const bf16_t* hb = WSP(bf16_t, WS_H);
        f32x4 wv[4], shv[4];
        load_mod8(IN(21), mods, 0, 6, lane, wv, shv); norm_rows_h(hb, xn, L, wv, shv, gw, ngw, lane);
        load_mod8(IN(21), mods, 1, 6, lane, wv, shv); norm_rows_h(hb + (size_t)L * D, xn + (size_t)L * D, L, wv, shv, gw, ngw, lane);
    }
    GSYNC();
    { PHASE_BEGIN
      GridSched S{(const char*)(ws + WS_XN), (const char*)(ws + WS_WFFN2IN), D * 2, D * 2, 16, T / 256, 2 * DFF / 256, G, bid}; EpiFfnIn E; E.act = WSP(bf16_t, WS_ACT); gemm_phase(lds, S, E); }
    GSYNC();
    { PHASE_BEGIN
      GridSched S{(const char*)(ws + WS_ACT), (const char*)(ws + WS_WFFN2OUT), DFF * 2, DFF * 2, DFF / 64, T / 256, 4, G, bid};
      EpiResid<true> E; E.res_f32 = nullptr; E.hbuf = WSP(bf16_t, WS_H); E.dst_ctx = nullptr; E.mods = WSP(float, WS_MODS); E.gidx = 8; E.coef = 0.5f; gemm_phase(lds, S, E); }
    GSYNC();
    {
        PHASE_BEGIN
        const float* fw = IN(24); float* out = pp->out; const bf16_t* hb = WSP(bf16_t, WS_H);
        f32x4 wv[4];
#pragma unroll
        for (int j = 0; j < 2; ++j)
#pragma unroll
            for (int q = 0; q < 2; ++q) wv[2 * j + q] = *(const f32x4*)(fw + 8 * lane + 512 * j + 4 * q);
        for (int row0 = gw * 2; row0 < T; row0 += ngw * 2) {
            u32x4 raw[2][2];
#pragma unroll
            for (int rr = 0; rr < 2; ++rr)
#pragma unroll
                for (int j = 0; j < 2; ++j) raw[rr][j] = __builtin_nontemporal_load((const u32x4*)(hb + (size_t)(row0 + rr) * D + 8 * lane + 512 * j));
#pragma unroll
            for (int rr = 0; rr < 2; ++rr) {
                f32x4 v[4]; float ss = 0.f;
#pragma unroll
                for (int j = 0; j < 2; ++j) unpack8(raw[rr][j], v[2 * j], v[2 * j + 1]);
#pragma unroll
                for (int q = 0; q < 4; ++q) ss += (v[q][0] * v[q][0] + v[q][1] * v[q][1]) + (v[q][2] * v[q][2] + v[q][3] * v[q][3]);
                const float r = rsqrtf(wave_sum(ss, lane) * (1.0f / D) + EPS);
                float* o = out + (size_t)(row0 + rr) * D + 8 * lane;
#pragma unroll
                for (int j = 0; j < 2; ++j) { __builtin_nontemporal_store(v[2 * j] * r * wv[2 * j], (f32x4*)(o + 512 * j)); __builtin_nontemporal_store(v[2 * j + 1] * r * wv[2 * j + 1], (f32x4*)(o + 512 * j + 4)); }
            }
        }
    }
}

constexpr int LDS_BYTES = 144 * 1024;

extern "C" void kernel_launch(void* const* d_in, const int* in_sizes, int n_in, void* d_out, int out_size, void* d_ws, size_t ws_size, hipStream_t stream) {
    static int grid_blocks = 0;
    if (grid_blocks == 0) {
        if (n_in != 25 || out_size != T * D || ws_size < WS_END) { fprintf(stderr, "kernel_launch: unexpected shapes (n_in %d out %d ws %zu need %zu)\n", n_in, out_size, ws_size, (size_t)WS_END); grid_blocks = -1; return; }
        int dev = 0, cus = 0, per_cu = 0;
        hipGetDevice(&dev);
        hipDeviceGetAttribute(&cus, hipDeviceAttributeMultiprocessorCount, dev);
        if (hipFuncSetAttribute((const void*)fwd_megakernel, hipFuncAttributeMaxDynamicSharedMemorySize, LDS_BYTES) != hipSuccess) { fprintf(stderr, "kernel_launch: hipFuncSetAttribute failed\n"); grid_blocks = -1; return; }
        if (hipOccupancyMaxActiveBlocksPerMultiprocessor(&per_cu, (const void*)fwd_megakernel, 512, LDS_BYTES) != hipSuccess || per_cu < 1) { fprintf(stderr, "kernel_launch: occupancy query says %d blocks per CU\n", per_cu); grid_blocks = -1; return; }
        grid_blocks = cus;
        if (grid_blocks > 256) grid_blocks = 256;
    }
    if (grid_blocks < 0) return;
    if (hipMemsetAsync((char*)d_ws + WS_BAR, 0, XCD_BAR_WORDS * sizeof(unsigned), stream) != hipSuccess) { fprintf(stderr, "kernel_launch: memset of the barrier words failed\n"); return; }
    Params p{};
    for (int i = 0; i < 25; ++i) p.in[i] = (const float*)d_in[i];
    p.out = (float*)d_out; p.ws = (unsigned char*)d_ws;
    void* args[] = {&p};
    hipError_t e = hipLaunchCooperativeKernel((const void*)fwd_megakernel, dim3(grid_blocks), dim3(512), args, LDS_BYTES, stream);
    if (e != hipSuccess) fprintf(stderr, "cooperative launch failed: %s (grid %d)\n", hipGetErrorString(e), grid_blocks);
}
```

```cpp
#include <hip/hip_runtime.h>
#include <hip/hip_cooperative_groups.h>
#include <cstdio>
#include <cstdint>
namespace cg = cooperative_groups;

#define LAS __attribute__((address_space(3)))
typedef unsigned short bf16_t;
typedef short bf16x8 __attribute__((ext_vector_type(8)));
typedef float f32x4 __attribute__((ext_vector_type(4)));
typedef float f32x2 __attribute__((ext_vector_type(2)));
typedef unsigned u32x4 __attribute__((ext_vector_type(4)));
typedef unsigned u32x2 __attribute__((ext_vector_type(2)));

constexpr int D = 1024, NB = 2, L = 16384, T = NB * L, CTXL = 256, TC = NB * CTXL, MALL = T + TC, DFF = 2816, INW = 10240, NMOD = 9;
constexpr int CH = 512, NCH = L / CH;
constexpr float EPS = 1e-6f;
constexpr size_t MiB = (size_t)1 << 20;
constexpr size_t WS_WFFN1IN = 0;
constexpr size_t WS_WFFN1OUT = WS_WFFN1IN + 11 * MiB;
constexpr size_t WS_WIN = WS_WFFN1OUT + 5 * MiB + MiB / 2;
constexpr size_t WS_WRET = WS_WIN + 20 * MiB;
constexpr size_t WS_WCONV = WS_WRET + 4 * MiB;
constexpr size_t WS_WOUT = WS_WCONV + 2 * MiB;
constexpr size_t WS_WFFN2IN = WS_WOUT + 2 * MiB;
constexpr size_t WS_WFFN2OUT = WS_WFFN2IN + 11 * MiB;
constexpr size_t WS_SMALL = 61 * MiB;
constexpr size_t WS_MODS = WS_SMALL;
constexpr size_t WS_DEC = WS_SMALL + 120 * 1024;
constexpr size_t WS_PART = WS_SMALL + 128 * 1024;
constexpr size_t WS_STATS = WS_SMALL + 1 * MiB;
constexpr size_t WS_BAR = WS_SMALL + 10 * MiB;
constexpr size_t WS_POOL = 72 * MiB;
constexpr size_t WS_XN = WS_POOL;
constexpr size_t WS_ACT = WS_POOL + 65 * MiB;
constexpr size_t WS_KTQK = WS_POOL + 65 * MiB;
constexpr size_t WS_VT = WS_POOL + 129 * MiB;
constexpr size_t WS_SB = WS_POOL + 193 * MiB;
constexpr size_t WS_PSCR = WS_POOL + 257 * MiB;
constexpr size_t WS_O = WS_POOL + 321 * MiB;
constexpr size_t WS_H = WS_O;
constexpr size_t WS_Y = WS_POOL + 65 * MiB;
constexpr size_t WS_Z = WS_POOL + 129 * MiB;
constexpr size_t WS_YR = WS_POOL + 193 * MiB;
constexpr size_t WS_YC = WS_Y;
constexpr size_t WS_SLAB = WS_O + 64 * MiB;
constexpr size_t WS_CTX = WS_POOL + 408 * MiB;
constexpr size_t CTX_STRIDE = 8 * MiB, CTX_KT = 4 * MiB, CTX_VT = 5 * MiB;
constexpr size_t WS_END = WS_POOL + 424 * MiB;

__device__ __forceinline__ unsigned pk2(float lo, float hi) { unsigned r; asm("v_cvt_pk_bf16_f32 %0, %1, %2" : "=v"(r) : "v"(lo), "v"(hi)); return r; }
__device__ __forceinline__ float bflo(unsigned u) { return __uint_as_float(u << 16); }
__device__ __forceinline__ float bfhi(unsigned u) { return __uint_as_float(u & 0xffff0000u); }
__device__ __forceinline__ float fsig(float x) { return __builtin_amdgcn_rcpf(1.0f + __builtin_amdgcn_exp2f(-1.4426950409f * x)); }
__device__ __forceinline__ float fsilu(float x) { return x * fsig(x); }
__device__ __forceinline__ float ex2(float x) { return __builtin_amdgcn_exp2f(x); }
__device__ __forceinline__ float wave_sum(float v, int lane) {
#pragma unroll
    for (int o = 1; o < 64; o <<= 1) v += __int_as_float(__builtin_amdgcn_ds_bpermute((lane ^ o) << 2, __float_as_int(v)));
    return v;
}
template <int N> __device__ __forceinline__ void wave_sum_n(float (&v)[N], int lane) {
#pragma unroll
    for (int o = 1; o < 64; o <<= 1) {
        float t[N];
#pragma unroll
        for (int i = 0; i < N; ++i) t[i] = __int_as_float(__builtin_amdgcn_ds_bpermute((lane ^ o) << 2, __float_as_int(v[i])));
#pragma unroll
        for (int i = 0; i < N; ++i) v[i] += t[i];
    }
}
__device__ __forceinline__ float wave_reduce16(const float (&v)[16], int lane) {
    float a[8], b[4], c[2], d;
    { const bool hi = (lane & 32) != 0;
#pragma unroll
      for (int i = 0; i < 8; ++i) { const float mine = hi ? v[8 + i] : v[i], send = hi ? v[i] : v[8 + i]; a[i] = mine + __int_as_float(__builtin_amdgcn_ds_bpermute((lane ^ 32) << 2, __float_as_int(send))); } }
    { const bool hi = (lane & 16) != 0;
#pragma unroll
      for (int i = 0; i < 4; ++i) { const float mine = hi ? a[4 + i] : a[i], send = hi ? a[i] : a[4 + i]; b[i] = mine + __int_as_float(__builtin_amdgcn_ds_bpermute((lane ^ 16) << 2, __float_as_int(send))); } }
    { const bool hi = (lane & 8) != 0;
#pragma unroll
      for (int i = 0; i < 2; ++i) { const float mine = hi ? b[2 + i] : b[i], send = hi ? b[i] : b[2 + i]; c[i] = mine + __int_as_float(__builtin_amdgcn_ds_bpermute((lane ^ 8) << 2, __float_as_int(send))); } }
    { const bool hi = (lane & 4) != 0; const float mine = hi ? c[1] : c[0], send = hi ? c[0] : c[1]; d = mine + __int_as_float(__builtin_amdgcn_ds_bpermute((lane ^ 4) << 2, __float_as_int(send))); }
    d += __int_as_float(__builtin_amdgcn_ds_bpermute((lane ^ 2) << 2, __float_as_int(d)));
    d += __int_as_float(__builtin_amdgcn_ds_bpermute((lane ^ 1) << 2, __float_as_int(d)));
    return d;
}
__device__ __forceinline__ u32x4 pack8(const f32x4 a, const f32x4 b) { u32x4 w; w.x = pk2(a[0], a[1]); w.y = pk2(a[2], a[3]); w.z = pk2(b[0], b[1]); w.w = pk2(b[2], b[3]); return w; }
__device__ __forceinline__ void unpack8(const u32x4 w, f32x4& a, f32x4& b) { a[0] = bflo(w.x); a[1] = bfhi(w.x); a[2] = bflo(w.y); a[3] = bfhi(w.y); b[0] = bflo(w.z); b[1] = bfhi(w.z); b[2] = bflo(w.w); b[3] = bfhi(w.w); }


#define XB_TMO      128
#define XB_XCNT(j)  (256  + 64 * (j))
#define XB_XSUB(j)  (1280 + 64 * (j))
#define XB_XGEN(j)  (2304 + 64 * (j))
#define XB_TOP      3328
#define XB_TOPGEN   3392
#define XCD_BAR_WORDS 3456
#define XB_SPIN_CAP (1u << 20)
__device__ __forceinline__ unsigned xb_ld(unsigned* p)              { return __hip_atomic_load(p, __ATOMIC_RELAXED, __HIP_MEMORY_SCOPE_AGENT); }
__device__ __forceinline__ unsigned xb_add(unsigned* p, unsigned v) { return __hip_atomic_fetch_add(p, v, __ATOMIC_RELAXED, __HIP_MEMORY_SCOPE_AGENT); }
__device__ __forceinline__ unsigned xb_xcc_id() { return (unsigned)__builtin_amdgcn_s_getreg((3 << 11) | 20) & 0xFu; }
#define XB_SPIN(cond, bar) do { unsigned _sp = 0; while (cond) { __builtin_amdgcn_s_sleep(1); \
    if ((++_sp & 255u) == 0u) { if (xb_ld(&(bar)[XB_TMO])) break; if (_sp > XB_SPIN_CAP) { atomicAdd(&(bar)[XB_TMO], 1u); break; } } } } while (0)
struct XcdBarrier { unsigned* bar; unsigned x; volatile LAS unsigned* st; };
__device__ __forceinline__ void xcd_barrier_complete(unsigned* bar, unsigned x, unsigned& nloc, unsigned& nx) {
    const unsigned G = gridDim.x * gridDim.y * gridDim.z;
    unsigned sum, cnt, mine, sp = 0u;
    for (;;) {
        sum = 0u; cnt = 0u; mine = 0u;
#pragma unroll
        for (unsigned j = 0; j < 16; ++j) { const unsigned c = xb_ld(&bar[XB_XCNT(j)]); sum += c; cnt += (c > 0u) ? 1u : 0u; mine = (j == x) ? c : mine; }
        if (sum == G) break;
        __builtin_amdgcn_s_sleep(1);
        if ((++sp & 255u) == 0u) { if (xb_ld(&bar[XB_TMO])) break; if (sp > XB_SPIN_CAP) { atomicAdd(&bar[XB_TMO], 1u); break; } }
    }
    nloc = mine > 0u ? mine : 1u; nx = cnt > 0u ? cnt : 1u;
}
__device__ __forceinline__ void xcd_barrier(const XcdBarrier& b) {
    asm volatile("s_waitcnt vmcnt(0)" ::: "memory");
    __syncthreads();
    if (threadIdx.x == 0) {
        unsigned* bar = b.bar;
        __builtin_amdgcn_s_waitcnt(0);
        unsigned nloc = b.st[0], nx = b.st[1];
        if (nloc == 0u) { xcd_barrier_complete(bar, b.x, nloc, nx); b.st[0] = nloc; b.st[1] = nx; }
        const unsigned old = xb_add(&bar[XB_XSUB(b.x)], 1u);
        const unsigned gen = old / nloc;
        if (old + 1u == (gen + 1u) * nloc) {
            __builtin_amdgcn_fence(__ATOMIC_RELEASE, "agent");
            asm volatile("s_waitcnt vmcnt(0)" ::: "memory");
            const unsigned og = xb_add(&bar[XB_TOP], 1u);
            const unsigned tg = og / nx;
            if (og + 1u == (tg + 1u) * nx) xb_add(&bar[XB_TOPGEN], 1u);
            else XB_SPIN(xb_ld(&bar[XB_TOPGEN]) == tg, bar);
            __builtin_amdgcn_fence(__ATOMIC_ACQUIRE, "agent");
            xb_add(&bar[XB_XGEN(b.x)], 1u);
            asm volatile("s_waitcnt vmcnt(0)" ::: "memory");
        } else {
            XB_SPIN(xb_ld(&bar[XB_XGEN(b.x)]) == gen, bar);
            __builtin_amdgcn_fence(__ATOMIC_ACQUIRE, "agent");
            asm volatile("s_waitcnt vmcnt(0)" ::: "memory");
        }
    }
    __syncthreads();
}

constexpr int BM = 256, BK = 64, HALF = 128, HTB = HALF * BK * 2, STAGE_BYTES = 8 * HTB, NXCD = 8, WGM = 8;
__device__ __forceinline__ int lds_byte(int r, int c) { const int st = (r >> 4) * 2 + (c >> 5), rr = r & 15, cc = c & 31, ob = rr * 64 + cc * 2; return st * 1024 + (ob ^ (((ob >> 9) & 1) << 5)); }
__device__ __forceinline__ void stage_rc(int b, int& R, int& C) { const int st = b / 1024, sb = b % 1024, swz = sb ^ (((sb >> 9) & 1) << 5); R = (st >> 1) * 16 + swz / 64; C = (st & 1) * 32 + (swz % 64) / 2; }
__device__ __forceinline__ int perm32(int rho) { const int n = rho >> 4, i = rho & 15; return 8 * (i >> 2) + 4 * n + (i & 3); }

struct Unit { const char* A; const char* B; int lda2, ldb2, nt, kind, pm, pn, z, w; };

__device__ __forceinline__ bool tile_of(long Lidx, int nM, int nN, int& pm, int& pn) {
    const int nwg = nM * nN; if (Lidx >= nwg) return false;
    int wgid = (int)Lidx; { const int q = nwg / NXCD, r = nwg % NXCD, xcd = wgid % NXCD, off = wgid / NXCD; wgid = (xcd < r ? xcd * (q + 1) : r * (q + 1) + (xcd - r) * q) + off; }
    const int nig = WGM * nN, gid = wgid / nig, fm = gid * WGM, gsz = (nM - fm) < WGM ? (nM - fm) : WGM;
    pm = fm + ((wgid % nig) % gsz); pn = (wgid % nig) / gsz; return true;
}
struct EpiBase { __device__ __forceinline__ void a_ready(const Unit&) const {} };

#define ROWLOC(ai, m) (128 * (ai) + 64 * wr + 16 * (m) + fr)
#define COLLOC(bj) (128 * (bj) + 32 * wc + 8 * fq)

template <class Epi, class Sched>
__device__ __forceinline__ void gemm_phase(LAS unsigned char* lds, const Sched& S, const Epi& E) {
    int tid = threadIdx.x; asm volatile("" : "+v"(tid));
    const int wid = __builtin_amdgcn_readfirstlane(tid >> 6), lane = tid & 63, wr = wid >> 2, wc = wid & 3, fr = lane & 15, fq = lane >> 4;
    int sR, sRb, sC2;
    { int R, C; stage_rc(tid * 16, R, C); sR = R; sRb = (R & ~31) + perm32(R & 31); sC2 = C * 2; }
    const size_t kstep = (size_t)(BK * 2);
    const unsigned ldsbase = (unsigned)(size_t)lds + (unsigned)wid * 1024u;
    const int aoff = lds_byte(wr * 64 + fr, fq * 8), boff = lds_byte(wc * 32 + fr, fq * 8);
#define PG8_SA(b, h) (((b) * 2 + (h)) * HTB)
#define PG8_SB(b, h) ((4 + (b) * 2 + (h)) * HTB)
#define PG8_STAGE(bufoff, gbase, voff, p64) do { _Pragma("unroll") for (int _i = 0; _i < 2; ++_i) { \
        const char* _gb = (const char*)(gbase) + (size_t)_i * (p64); const unsigned _la = ldsbase + (unsigned)(bufoff) + (unsigned)_i * 8192u; \
        asm volatile("s_mov_b32 m0, %0\n\ts_nop 0\n\tglobal_load_lds_dwordx4 %1, %2" :: "s"(_la), "v"(voff), "s"(_gb) : "memory"); } } while (0)
#define PG8_LDA(dst, b, h) do { _Pragma("unroll") for (int m = 0; m < 4; ++m) _Pragma("unroll") for (int k = 0; k < 2; ++k) dst[m][k] = *(const LAS bf16x8*)(lds + PG8_SA(b, h) + aoff + m * 2048 + k * 1024); } while (0)
#define PG8_LDB(dst, b, h) do { _Pragma("unroll") for (int n = 0; n < 2; ++n) _Pragma("unroll") for (int k = 0; k < 2; ++k) dst[n][k] = *(const LAS bf16x8*)(lds + PG8_SB(b, h) + boff + n * 2048 + k * 1024); } while (0)
#define PG8_MMA(ai, bj, At, Bt) do { __builtin_amdgcn_s_setprio(1); _Pragma("unroll") for (int m = 0; m < 4; ++m) _Pragma("unroll") for (int n = 0; n < 2; ++n) _Pragma("unroll") for (int k = 0; k < 2; ++k) \
        acc[ai][bj][m][n] = __builtin_amdgcn_mfma_f32_16x16x32_bf16(Bt[n][k], At[m][k], acc[ai][bj][m][n], 0, 0, 0); __builtin_amdgcn_s_setprio(0); } while (0)
#define PG8_WAIT_V(n) asm volatile("s_waitcnt vmcnt(" #n ")" ::: "memory")
#define PG8_WAIT_L(n) asm volatile("s_waitcnt lgkmcnt(" #n ")" ::: "memory")
#define PG8_BAR __builtin_amdgcn_s_barrier()
#define PG8_SCHED __builtin_amdgcn_sched_barrier(0)
    int ui = 0;
    const char* cA; const char* cB; unsigned hA, hB; int nt; unsigned voffA, voffB;
    { Unit u0; if (!S.next(0, u0)) return;
      cA = u0.A; cB = u0.B; hA = (unsigned)HALF * u0.lda2; hB = (unsigned)HALF * u0.ldb2; nt = u0.nt;
      voffA = (unsigned)(sR * u0.lda2 + sC2); voffB = (unsigned)(sRb * u0.ldb2 + sC2); }
    f32x4 acc[2][2][4][2];
#pragma unroll
    for (int a = 0; a < 2; ++a)
#pragma unroll
        for (int b = 0; b < 2; ++b)
#pragma unroll
            for (int m = 0; m < 4; ++m)
#pragma unroll
                for (int n = 0; n < 2; ++n) acc[a][b][m][n] = (f32x4){0.f, 0.f, 0.f, 0.f};
    bf16x8 At[4][2], B0[2][2], B1[2][2];
    PG8_STAGE(PG8_SB(0, 0), cB, voffB, hB / 2); PG8_STAGE(PG8_SB(0, 1), cB + hB, voffB, hB / 2); PG8_STAGE(PG8_SA(0, 0), cA, voffA, hA / 2); PG8_STAGE(PG8_SA(0, 1), cA + hA, voffA, hA / 2);
    if (wr == 1) PG8_BAR;
    PG8_WAIT_V(2); PG8_BAR;
    PG8_STAGE(PG8_SB(1, 0), cB + kstep, voffB, hB / 2); PG8_STAGE(PG8_SA(1, 0), cA + kstep, voffA, hA / 2); PG8_STAGE(PG8_SB(1, 1), cB + hB + kstep, voffB, hB / 2);
    PG8_WAIT_V(6); PG8_BAR;
    for (;;) {
        const char* nA = cA; const char* nB = cB; int nnt = nt; bool has_next;
        { Unit nx; has_next = S.next(ui + 1, nx);
          if (has_next) { nA = nx.A; nB = nx.B; nnt = nx.nt; } }
        for (int t = 0; t < nt; t += 2) {
            const bool last = (t == nt - 2);
            const char* a1 = cA + (size_t)(t + 1) * kstep;
            const char* a2 = last ? nA : cA + (size_t)(t + 2) * kstep; const char* b2 = last ? nB : cB + (size_t)(t + 2) * kstep;
            const char* a3 = a2 + kstep; const char* b3 = b2 + kstep;
            const unsigned vA2 = voffA, vB2 = voffB, hA2 = hA, hB2 = hB;
            PG8_LDB(B0, 0, 0); PG8_LDB(B1, 0, 1); PG8_SCHED; PG8_LDA(At, 0, 0); PG8_STAGE(PG8_SA(1, 1), a1 + hA, voffA, hA / 2);
            PG8_WAIT_V(8); PG8_WAIT_L(0); PG8_BAR; PG8_MMA(0, 0, At, B0); PG8_MMA(0, 1, At, B1); PG8_BAR; PG8_SCHED;
            PG8_LDA(At, 0, 1); PG8_STAGE(PG8_SB(0, 0), b2, vB2, hB2 / 2); PG8_STAGE(PG8_SB(0, 1), b2 + hB2, vB2, hB2 / 2); PG8_STAGE(PG8_SA(0, 0), a2, vA2, hA2 / 2);
            PG8_WAIT_V(8); PG8_WAIT_L(0); PG8_BAR; PG8_MMA(1, 0, At, B0); PG8_MMA(1, 1, At, B1); PG8_BAR; PG8_SCHED;
            PG8_LDB(B0, 1, 0); PG8_LDB(B1, 1, 1); PG8_SCHED; PG8_LDA(At, 1, 0); PG8_STAGE(PG8_SA(0, 1), a2 + hA2, vA2, hA2 / 2);
            PG8_WAIT_V(8); PG8_WAIT_L(0); PG8_BAR; PG8_MMA(0, 0, At, B0); PG8_MMA(0, 1, At, B1); PG8_BAR; PG8_SCHED;
            PG8_LDA(At, 1, 1); PG8_STAGE(PG8_SB(1, 0), b3, vB2, hB2 / 2); PG8_STAGE(PG8_SB(1, 1), b3 + hB2, vB2, hB2 / 2); PG8_STAGE(PG8_SA(1, 0), a3, vA2, hA2 / 2);
            PG8_WAIT_V(8); PG8_WAIT_L(0); PG8_BAR; PG8_MMA(1, 0, At, B0); PG8_MMA(1, 1, At, B1); PG8_BAR; PG8_SCHED;
        }
        if (wr == 0) PG8_BAR;
        bool keep;
        { int efr = fr, efq = fq, eui = ui; asm volatile("" : "+v"(efr), "+v"(efq), "+s"(eui));
          Unit eu; S.next(eui, eu); keep = E(acc, eu, wr, wc, efr, efq); }
        if (!has_next) break;
        if (!keep) {
#pragma unroll
            for (int a = 0; a < 2; ++a)
#pragma unroll
                for (int b = 0; b < 2; ++b)
#pragma unroll
                    for (int m = 0; m < 4; ++m)
#pragma unroll
                        for (int n = 0; n < 2; ++n) acc[a][b][m][n] = (f32x4){0.f, 0.f, 0.f, 0.f};
        }
        cA = nA; cB = nB; nt = nnt; ++ui;
        if (wr == 1) PG8_BAR;
    }
    PG8_WAIT_V(0);
    PG8_BAR;
#undef PG8_SA
#undef PG8_SB
#undef PG8_STAGE
#undef PG8_LDA
#undef PG8_LDB
#undef PG8_MMA
#undef PG8_WAIT_V
#undef PG8_WAIT_L
#undef PG8_BAR
#undef PG8_SCHED
}

struct GridSched {
    const char* A; const char* B; int lda2, ldb2, nt, nM, nN, G, c;
    __device__ __forceinline__ bool next(int i, Unit& u) const {
        int pm, pn; if (!tile_of((long)i * G + c, nM, nN, pm, pn)) return false;
        u.A = A + (size_t)pm * 256 * lda2; u.B = B + (size_t)pn * 256 * ldb2; u.lda2 = lda2; u.ldb2 = ldb2; u.nt = nt; u.kind = 0; u.pm = pm; u.pn = pn; u.z = 0; u.w = 0; return true;
    }
};
struct Ffn1OutSched {
    const char* A; const char* B; int G, c;
    __device__ __forceinline__ bool next(int i, Unit& u) const {
        const int Lx = i * G + c; u.lda2 = DFF * 2; u.ldb2 = DFF * 2; u.z = 0; u.w = 0;
        if (Lx < 512) { int pm, pn; tile_of(Lx, 128, 4, pm, pn); u.pm = pm; u.pn = pn; u.kind = 0; u.nt = DFF / 64;
            u.A = A + (size_t)pm * 256 * (DFF * 2); u.B = B + (size_t)pn * 256 * (DFF * 2); return true; }
        const int e = Lx - 512; if (e >= 88) return false;
        const int t = e / 11, ks = e % 11; u.pm = 128 + (t >> 2); u.pn = t & 3; u.kind = 1; u.nt = 4; u.w = ks;
        u.A = A + (size_t)u.pm * 256 * (DFF * 2) + ks * 512; u.B = B + (size_t)u.pn * 256 * (DFF * 2) + ks * 512; return true;
    }
};
struct USched {
    const char* vt; const char* ktf; const char* ktb; int G, c;
    __device__ __forceinline__ bool next(int i, Unit& u) const {
        const int idx = i * G + c; if (idx >= 4 * NCH * 2 * 2) return false;
        const int pm = idx & 1, dir = (idx >> 1) & 1, n = (idx >> 2) & (NCH - 1), h = idx >> 7;
        u.A = vt + ((size_t)((h * NCH + n) * 512 + pm * 256) * 512) * 2; u.B = (dir ? ktb : ktf) + ((size_t)((h * NCH + n) * 256) * 512) * 2;
        u.lda2 = CH * 2; u.ldb2 = CH * 2; u.nt = CH / 64; u.kind = dir; u.pm = pm; u.pn = n; u.z = h; u.w = 0; return true;
    }
};
struct UCtxSched {
    const char* vtc; const char* ktcf; const char* ktcb; int G, c;
    __device__ __forceinline__ bool next(int i, Unit& u) const {
        const int idx = i * G + c; if (idx >= 32) return false;
        const int pm = idx & 1, dir = (idx >> 1) & 1, h = (idx >> 2) & 3, bb = idx >> 4;
        u.A = vtc + (size_t)bb * CTX_STRIDE + ((size_t)(h * 512 + pm * 256) * CTXL) * 2; u.B = (dir ? ktcb : ktcf) + (size_t)bb * CTX_STRIDE + ((size_t)(h * 256) * CTXL) * 2;
        u.lda2 = CTXL * 2; u.ldb2 = CTXL * 2; u.nt = CTXL / 64; u.kind = dir; u.pm = pm; u.pn = 0; u.z = h; u.w = bb; return true;
    }
};
struct QKSched {
    const char* q; const char* k; int item;
    __device__ __forceinline__ bool next(int i, Unit& u) const {
        if (i >= 2) return false;
        const int ib = item & 1, h = (item >> 1) & 3, n = item >> 3;
        u.pm = ib; u.pn = n; u.z = h; u.kind = 0; u.w = i; u.lda2 = D * 2; u.ldb2 = D * 2; u.nt = 4;
        u.A = q + ((size_t)(n * CH + ib * 256) * D + h * 256) * 2; u.B = k + ((size_t)(n * CH + i * 256) * D + h * 256) * 2;
        return true;
    }
};
struct SVSched {
    const char* qa; const char* sbb; const char* vtb; const char* pscr; int item;
    __device__ __forceinline__ bool next(int i, Unit& u) const {
        if (i >= 6) return false;
        const int dvt = i >= 3 ? 1 : 0, s3 = i - 3 * dvt;
        u.pm = item & 1; u.pn = item >> 3; u.z = (item >> 1) & 3; u.kind = 1 + s3; u.w = dvt; u.lda2 = D * 2; u.ldb2 = CH * 2;
        const size_t dvo = (size_t)dvt * (256 * (size_t)CH * 2);
        u.A = s3 < 2 ? qa : pscr; u.B = (s3 < 2 ? sbb + s3 * 512 : vtb) + dvo; u.nt = s3 < 2 ? 4 : 8;
        return true;
    }
};

#define EPI_ARGS f32x4 (&acc)[2][2][4][2], const Unit& u, int wr, int wc, int fr, int fq
struct EpiFfnIn : EpiBase {
    bf16_t* act;
    __device__ __forceinline__ bool operator()(EPI_ARGS) const {
#pragma unroll
        for (int ai = 0; ai < 2; ++ai)
#pragma unroll
            for (int m = 0; m < 4; ++m) {
                const size_t row = (size_t)u.pm * 256 + ROWLOC(ai, m);
                const f32x4 a0 = acc[ai][0][m][0], a1 = acc[ai][0][m][1], b0 = acc[ai][1][m][0], b1 = acc[ai][1][m][1];
                const f32x4 t0 = a0 * (-1.4426950409f), t1 = a1 * (-1.4426950409f);
                f32x4 d0, d1;
#pragma unroll
                for (int e = 0; e < 4; ++e) { d0[e] = ex2(t0[e]); d1[e] = ex2(t1[e]); }
                d0 = d0 + 1.0f; d1 = d1 + 1.0f;
                f32x4 r0, r1;
#pragma unroll
                for (int e = 0; e < 4; ++e) { r0[e] = __builtin_amdgcn_rcpf(d0[e]); r1[e] = __builtin_amdgcn_rcpf(d1[e]); }
                const f32x4 o0 = (a0 * b0) * r0, o1 = (a1 * b1) * r1;
                *(u32x4*)(act + row * DFF + u.pn * 128 + 32 * wc + 8 * fq) = pack8(o0, o1);
            }
        return false;
    }
};
template <bool RES_BF16> struct EpiResid : EpiBase {
    const float* res_f32; bf16_t* hbuf; float* dst_ctx; const float* mods; int gidx; float coef;
    __device__ __forceinline__ bool operator()(EPI_ARGS) const {
        const int ms = u.pm < 64 ? 0 : (u.pm < 128 ? 1 : 2);
        const float* g = mods + ms * (NMOD * D) + gidx * D;
#pragma unroll
        for (int bj = 0; bj < 2; ++bj) {
            const int col = u.pn * 256 + COLLOC(bj);
            const f32x4 g0 = *(const f32x4*)(g + col) * coef, g1 = *(const f32x4*)(g + col + 4) * coef;
            if (u.kind == 1) {
                float* dst = dst_ctx + (size_t)(u.pm - 128) * 256 * D;
#pragma unroll
                for (int ai = 0; ai < 2; ++ai)
#pragma unroll
                    for (int m = 0; m < 4; ++m) {
                        float* sl = dst + (size_t)u.w * (TC * D) + (size_t)ROWLOC(ai, m) * D + col;
                        *(f32x4*)sl = g0 * acc[ai][bj][m][0]; *(f32x4*)(sl + 4) = g1 * acc[ai][bj][m][1];
                    }
            } else {
                bf16_t* hp = hbuf + (size_t)u.pm * 256 * D;
#pragma unroll
                for (int ai = 0; ai < 2; ++ai) {
                    f32x4 r0[4], r1[4];
#pragma unroll
                    for (int m = 0; m < 4; ++m) { const size_t o = (size_t)ROWLOC(ai, m) * D + col;
                        if (RES_BF16) unpack8(*(const u32x4*)(hp + o), r0[m], r1[m]);
                        else { const float* rp = res_f32 + (size_t)u.pm * 256 * D + o; r0[m] = *(const f32x4*)rp; r1[m] = *(const f32x4*)(rp + 4); } }
#pragma unroll
                    for (int m = 0; m < 4; ++m) { const size_t o = (size_t)ROWLOC(ai, m) * D + col;
                        *(u32x4*)(hp + o) = pack8(r0[m] + g0 * acc[ai][bj][m][0], r1[m] + g1 * acc[ai][bj][m][1]); }
                }
            }
        }
        return false;
    }
};
constexpr float ROPE_C = 0.20762050593046014f;
constexpr float INV2PI = 0.15915494309189535f;
struct EpiProjT : EpiBase {
    bf16_t* ktf; bf16_t* ktb; bf16_t* vt; const float* dec; int ld, clen, rope;
    __device__ __forceinline__ bool operator()(EPI_ARGS) const {
        const int l0 = rope ? u.pn * 256 : 0;
        bf16_t* ktf = this->ktf; bf16_t* ktb = this->ktb; bf16_t* vt = this->vt;
        if (!rope) { const size_t bo = (size_t)u.pn * (CTX_STRIDE / 2); ktf += bo; ktb += bo; vt += bo; }
        if (u.pm >= 4) {
#pragma unroll
            for (int ai = 0; ai < 2; ++ai)
#pragma unroll
                for (int m = 0; m < 4; ++m) {
                    const int r = (u.pm - 4) * 256 + ROWLOC(ai, m);
                    const size_t rb = rope ? ((size_t)((r >> 9) * NCH + (u.pn >> 1)) * 512 + (r & 511)) * 512 + (u.pn & 1) * 256 : (size_t)r * ld + l0;
#pragma unroll
                    for (int bj = 0; bj < 2; ++bj) *(u32x4*)(vt + rb + COLLOC(bj)) = pack8(acc[ai][bj][m][0], acc[ai][bj][m][1]);
                }
        } else {
            const int h = u.pm; const float lgf = dec[h], lgb = dec[4 + h];
#pragma unroll
            for (int bj = 0; bj < 2; ++bj) {
                const int lb = l0 + COLLOC(bj);
#pragma unroll
                for (int m = 0; m < 4; ++m) {
                    const float invrev = ex2(-(float)(16 * m + fr) * ROPE_C) * INV2PI;
                    f32x4 f1[2], f2[2], b1[2], b2[2];
#pragma unroll
                    for (int n = 0; n < 2; ++n)
#pragma unroll
                        for (int e = 0; e < 4; ++e) {
                            const int l = lb + 4 * n + e, s = l & (clen - 1);
                            const float df = 0.0625f * ex2((float)(clen - 1 - s) * lgf), db = 0.0625f * ex2((float)s * lgb);
                            const float x1 = acc[0][bj][m][n][e], x2 = acc[1][bj][m][n][e];
                            float o1 = x1, o2 = x2;
                            if (rope) { const float rev = (float)(wr ? (l & 63) : (l >> 6)) * invrev; const float cs = __builtin_amdgcn_cosf(rev), sn = __builtin_amdgcn_sinf(rev); o1 = x1 * cs - x2 * sn; o2 = x1 * sn + x2 * cs; }
                            f1[n][e] = o1 * df; f2[n][e] = o2 * df; b1[n][e] = o1 * db; b2[n][e] = o2 * db;
                        }
                    const int cp = 64 * wr + 16 * m + fr;
                    const size_t r1 = rope ? ((size_t)(h * NCH + (u.pn >> 1)) * 256 + cp) * 512 + (u.pn & 1) * 256 + COLLOC(bj) : (size_t)(h * 256 + cp) * ld + lb;
                    const size_t r2 = r1 + (size_t)128 * (rope ? 512 : ld);
                    *(u32x4*)(ktf + r1) = pack8(f1[0], f1[1]); *(u32x4*)(ktf + r2) = pack8(f2[0], f2[1]);
                    *(u32x4*)(ktb + r1) = pack8(b1[0], b1[1]); *(u32x4*)(ktb + r2) = pack8(b2[0], b2[1]);
                }
            }
        }
        return false;
    }
};
struct EpiU : EpiBase {
    bf16_t* sb; float* rfb; int ctx;
    __device__ __forceinline__ bool operator()(EPI_ARGS) const {
        const int h = u.z, n = u.pn, dir = u.kind;
#pragma unroll
        for (int ai = 0; ai < 2; ++ai)
#pragma unroll
            for (int m = 0; m < 4; ++m) {
                const int dv = u.pm * 256 + ROWLOC(ai, m);
#pragma unroll
                for (int bj = 0; bj < 2; ++bj) {
                    const int dk = COLLOC(bj);
                    if (!ctx) *(u32x4*)(sb + ((size_t)((h * NCH + n) * 512 + dv)) * 512 + dir * 256 + dk) = pack8(acc[ai][bj][m][0], acc[ai][bj][m][1]);
                    else { float* p = rfb + (size_t)u.w * (CTX_STRIDE / 4) + ((size_t)((h * 2 + dir) * 512 + dv)) * 256 + dk; *(f32x4*)p = acc[ai][bj][m][0]; *(f32x4*)(p + 4) = acc[ai][bj][m][1]; }
                }
            }
        return false;
    }
};
struct EpiQK : EpiBase {
    bf16_t* q; bf16_t* k;
    __device__ __forceinline__ bool operator()(EPI_ARGS) const {
        const int isk = u.pn >= 4, h = u.pn & 3; bf16_t* dst = isk ? k : q; const float sc = isk ? 0.0625f : 1.0f;
        float invrev[8];
#pragma unroll
        for (int e = 0; e < 8; ++e) invrev[e] = ex2(-(float)((32 * wc + 8 * fq + e) & 63) * ROPE_C) * INV2PI;
#pragma unroll
        for (int ai = 0; ai < 2; ++ai)
#pragma unroll
            for (int m = 0; m < 4; ++m) {
                const int l = u.pm * 256 + ROWLOC(ai, m);
                const float pos = (float)(wc >= 2 ? (l & 63) : (l >> 6));
                f32x4 o1[2], o2[2];
#pragma unroll
                for (int n = 0; n < 2; ++n)
#pragma unroll
                    for (int e = 0; e < 4; ++e) {
                        const float x1 = acc[ai][0][m][n][e], x2 = acc[ai][1][m][n][e];
                        const float rev = pos * invrev[4 * n + e]; const float cs = __builtin_amdgcn_cosf(rev) * sc, sn = __builtin_amdgcn_sinf(rev) * sc;
                        o1[n][e] = x1 * cs - x2 * sn; o2[n][e] = x1 * sn + x2 * cs;
                    }
                bf16_t* p = dst + (size_t)l * D + h * 256 + 32 * wc + 8 * fq;
                *(u32x4*)p = pack8(o1[0], o1[1]); *(u32x4*)(p + 128) = pack8(o2[0], o2[1]);
            }
        return false;
    }
};
struct EpiP : EpiBase {
    bf16_t* pscr; const float* dec;
    __device__ __forceinline__ bool operator()(EPI_ARGS) const {
        const int h = u.z; const float lgf = dec[h], lgb = dec[4 + h];
#pragma unroll
        for (int ai = 0; ai < 2; ++ai)
#pragma unroll
            for (int m = 0; m < 4; ++m) {
                const int il = ROWLOC(ai, m), i = u.pm * 256 + il;
#pragma unroll
                for (int bj = 0; bj < 2; ++bj) {
                    const int j0 = u.w * 256 + COLLOC(bj);
                    f32x4 p[2];
#pragma unroll
                    for (int n = 0; n < 2; ++n)
#pragma unroll
                        for (int e = 0; e < 4; ++e) { const int d = i - (j0 + 4 * n + e); const float w = ex2(d >= 0 ? (float)d * lgf : (float)(-d) * lgb); p[n][e] = acc[ai][bj][m][n][e] * w; }
                    *(u32x4*)(pscr + (size_t)il * D + j0) = pack8(p[0], p[1]);
                }
            }
        return false;
    }
};
struct EpiSV : EpiBase {
    bf16_t* o; const float* dec;
    __device__ __forceinline__ bool operator()(EPI_ARGS) const {
        const int h = u.z; const float lgf = dec[h], lgb = dec[4 + h];
        const float c1 = u.kind == 1 ? lgf : 0.f, c2 = u.kind == 1 ? -lgb : (u.kind == 2 ? lgb : 0.f);
#pragma unroll
        for (int ai = 0; ai < 2; ++ai)
#pragma unroll
            for (int m = 0; m < 4; ++m) {
                const int i = u.pm * 256 + ROWLOC(ai, m);
                const float s = ex2((float)(i + 1) * c1 + (float)(CH - i) * c2);
#pragma unroll
                for (int bj = 0; bj < 2; ++bj)
#pragma unroll
                    for (int n = 0; n < 2; ++n)
#pragma unroll
                        for (int e = 0; e < 4; ++e) asm("s_nop 0\n\tv_mul_f32 %0, %0, %1" : "+v"(acc[ai][bj][m][n][e]) : "v"(s));
            }
        if (u.kind == 3) {
#pragma unroll
            for (int ai = 0; ai < 2; ++ai)
#pragma unroll
                for (int m = 0; m < 4; ++m) {
                    const size_t row = (size_t)u.pn * CH + u.pm * 256 + ROWLOC(ai, m);
#pragma unroll
                    for (int bj = 0; bj < 2; ++bj) *(u32x4*)(o + row * 2048 + h * 512 + u.w * 256 + COLLOC(bj)) = pack8(acc[ai][bj][m][0], acc[ai][bj][m][1]);
                }
        }
        return u.kind != 3;
    }
};
struct EpiRg : EpiBase {
    bf16_t* o; const float* stats; const float* gnw;
    __device__ __forceinline__ bool operator()(EPI_ARGS) const {
            const int head = u.pn >> 1;
#pragma unroll
            for (int bj = 0; bj < 2; ++bj) {
                const int col = u.pn * 256 + COLLOC(bj);
                const f32x4 w0 = *(const f32x4*)(gnw + col), w1 = *(const f32x4*)(gnw + col + 4);
#pragma unroll
                for (int ai = 0; ai < 2; ++ai) {
#pragma unroll
                    for (int mh = 0; mh < 4; mh += 2) {
                    f32x2 st[2]; u32x4 raw[2];
#pragma unroll
                    for (int m2 = 0; m2 < 2; ++m2) { const size_t row = (size_t)u.pm * 256 + ROWLOC(ai, mh + m2); st[m2] = *(const f32x2*)(stats + (row * 4 + head) * 2); raw[m2] = *(const u32x4*)(o + row * 2048 + col); }
#pragma unroll
                    for (int m2 = 0; m2 < 2; ++m2) {
                        const int m = mh + m2;
                        const size_t row = (size_t)u.pm * 256 + ROWLOC(ai, m);
                        f32x4 v0, v1; unpack8(raw[m2], v0, v1);
                        f32x4 r0, r1;
#pragma unroll
                        for (int e = 0; e < 4; ++e) { r0[e] = fsilu(acc[ai][bj][m][0][e]) * ((v0[e] - st[m2].x) * st[m2].y * w0[e]); r1[e] = fsilu(acc[ai][bj][m][1][e]) * ((v1[e] - st[m2].x) * st[m2].y * w1[e]); }
                        *(u32x4*)(o + row * 2048 + col) = pack8(r0, r1);
                    }
                    asm volatile("" ::: "memory");
                    }
                    asm volatile("" ::: "memory");
                }
            }
        return false;
    }
};
struct EpiCv : EpiBase {
    bf16_t* y;
    __device__ __forceinline__ bool operator()(EPI_ARGS) const {
            const int pt = u.pn;
#pragma unroll
            for (int ai = 0; ai < 2; ++ai)
#pragma unroll
                for (int m = 0; m < 4; ++m) {
                    const size_t row = (size_t)u.pm * 256 + ROWLOC(ai, m);
                    f32x4 o0, o1;
#pragma unroll
                    for (int e = 0; e < 4; ++e) { o0[e] = acc[ai][0][m][0][e] * fsig(acc[ai][1][m][0][e]); o1[e] = acc[ai][0][m][1][e] * fsig(acc[ai][1][m][1][e]); }
                    *(u32x4*)(y + row * D + pt * 128 + 32 * wc + 8 * fq) = pack8(o0, o1);
                }
        return false;
    }
};
struct EpiBf16 : EpiBase {
    bf16_t* dst; int ld;
    __device__ __forceinline__ bool operator()(EPI_ARGS) const {
#pragma unroll
        for (int ai = 0; ai < 2; ++ai)
#pragma unroll
            for (int m = 0; m < 4; ++m) {
                const size_t row = (size_t)u.pm * 256 + ROWLOC(ai, m);
#pragma unroll
                for (int bj = 0; bj < 2; ++bj) *(u32x4*)(dst + row * ld + u.pn * 256 + COLLOC(bj)) = pack8(acc[ai][bj][m][0], acc[ai][bj][m][1]);
            }
        return false;
    }
};
struct EpiGab : EpiBase {
    bf16_t* yr; const bf16_t* yc;
    __device__ __forceinline__ bool operator()(EPI_ARGS) const {
#pragma unroll
        for (int ai = 0; ai < 2; ++ai) {
            u32x4 ra[4], rc[4];
#pragma unroll
            for (int m = 0; m < 4; ++m) { const size_t off = ((size_t)u.pm * 256 + ROWLOC(ai, m)) * D + u.pn * 128 + 32 * wc + 8 * fq; ra[m] = *(const u32x4*)(yr + off); rc[m] = *(const u32x4*)(yc + off); }
#pragma unroll
            for (int m = 0; m < 4; ++m) {
                const size_t off = ((size_t)u.pm * 256 + ROWLOC(ai, m)) * D + u.pn * 128 + 32 * wc + 8 * fq;
                f32x4 a0, a1, c0, c1; unpack8(ra[m], a0, a1); unpack8(rc[m], c0, c1);
                f32x4 o0, o1;
#pragma unroll
                for (int e = 0; e < 4; ++e) { o0[e] = fsig(acc[ai][0][m][0][e]) * a0[e] + fsig(acc[ai][1][m][0][e]) * c0[e]; o1[e] = fsig(acc[ai][0][m][1][e]) * a1[e] + fsig(acc[ai][1][m][1][e]) * c1[e]; }
                *(u32x4*)(yr + off) = pack8(o0, o1);
            }
            asm volatile("" ::: "memory");
        }
        return false;
    }
};

__device__ __forceinline__ int rowmap_win(int n) {
    if (n < 2048) { const int d = n & 255; const int c = d < 64 ? d : (d < 128 ? d + 64 : (d < 192 ? d - 64 : d)); return (n & ~255) + c; }
    if (n < 6144) return n;
    if (n < 8192) { int j = n - 6144; const int g = j >> 10; j &= 1023; return 6144 + 256 * (j >> 7) + 128 * g + (j & 127); }
    { int j = n - 8192; const int g = j >> 10; j &= 1023; return 8192 + 256 * (j >> 7) + 128 * g + (j & 127); }
}
__device__ __forceinline__ int rowmap_ffn(int n) { if (n < DFF) return 256 * (n >> 7) + (n & 127); const int j = n - DFF; return 256 * (j >> 7) + 128 + (j & 127); }
__device__ __forceinline__ void transpose_item(const float* W, int K, int N, bf16_t* WT, int mapk, LAS float* scr, int item, int lane) {
    const int nblk = N / 32, kb = item / nblk, nb = item % nblk, k0 = 64 * kb, n0 = 32 * nb;
#pragma unroll 8
    for (int i = 0; i < 32; ++i) { const int kk = 2 * i + (lane >> 5); scr[kk * 33 + (lane & 31)] = __builtin_nontemporal_load(&W[(size_t)(k0 + kk) * N + n0 + (lane & 31)]); }
    asm volatile("s_waitcnt lgkmcnt(0)" ::: "memory");
    const int c = lane & 7;
#pragma unroll
    for (int j = 0; j < 4; ++j) { const int n = (lane >> 3) + 8 * j; const LAS float* s = scr + (8 * c) * 33 + n;
        u32x4 o; o.x = pk2(s[0 * 33], s[1 * 33]); o.y = pk2(s[2 * 33], s[3 * 33]); o.z = pk2(s[4 * 33], s[5 * 33]); o.w = pk2(s[6 * 33], s[7 * 33]);
        const int nn = n0 + n; const int row = mapk == 0 ? nn : (mapk == 1 ? rowmap_ffn(nn) : rowmap_win(nn));
        *(u32x4*)(WT + (size_t)row * K + k0 + 8 * c) = o; }
    asm volatile("s_waitcnt lgkmcnt(0)" ::: "memory");
}
__device__ __forceinline__ void norm_rows(const float* src, bf16_t* dst, int nrows, const f32x4 (&wv)[4], const f32x4 (&shv)[4], int gw, int ngw, int lane) {
    for (int row0 = gw * 2; row0 < nrows; row0 += ngw * 2) {
        f32x4 v[2][4]; float ss[2];
#pragma unroll
        for (int rr = 0; rr < 2; ++rr) { const float* s = src + (size_t)(row0 + rr) * D + 4 * lane;
#pragma unroll
            for (int j = 0; j < 4; ++j) v[rr][j] = *(const f32x4*)(s + 256 * j); }
#pragma unroll
        for (int rr = 0; rr < 2; ++rr) { float a = 0.f;
#pragma unroll
            for (int j = 0; j < 4; ++j) a += (v[rr][j][0] * v[rr][j][0] + v[rr][j][1] * v[rr][j][1]) + (v[rr][j][2] * v[rr][j][2] + v[rr][j][3] * v[rr][j][3]);
            ss[rr] = a; }
#pragma unroll
        for (int rr = 0; rr < 2; ++rr) {
            const float r = rsqrtf(wave_sum(ss[rr], lane) * (1.0f / D) + EPS);
            bf16_t* d = dst + (size_t)(row0 + rr) * D + 4 * lane;
#pragma unroll
            for (int j = 0; j < 4; ++j) { const f32x4 y = v[rr][j] * r * wv[j] + shv[j]; u32x2 o; o.x = pk2(y[0], y[1]); o.y = pk2(y[2], y[3]); *(u32x2*)(d + 256 * j) = o; }
        }
    }
}
__device__ __forceinline__ void load_mod8(const float* normw, const float* mods, int ms, int shidx, int lane, f32x4 (&wv)[4], f32x4 (&shv)[4]) {
#pragma unroll
    for (int j = 0; j < 2; ++j)
#pragma unroll
        for (int q = 0; q < 2; ++q) { const int c = 8 * lane + 512 * j + 4 * q;
            const f32x4 w = *(const f32x4*)(normw + c), sc = *(const f32x4*)(mods + ms * (NMOD * D) + (shidx + 1) * D + c);
            shv[2 * j + q] = *(const f32x4*)(mods + ms * (NMOD * D) + shidx * D + c); wv[2 * j + q] = w * (sc + 1.0f); }
}
__device__ __forceinline__ void norm_rows_h(const bf16_t* src, bf16_t* dst, int nrows, const f32x4 (&wv)[4], const f32x4 (&shv)[4], int gw, int ngw, int lane) {
    for (int row0 = gw * 2; row0 < nrows; row0 += ngw * 2) {
        u32x4 raw[2][2]; f32x4 v[2][4]; float ss[2];
#pragma unroll
        for (int rr = 0; rr < 2; ++rr)
#pragma unroll
            for (int j = 0; j < 2; ++j) raw[rr][j] = *(const u32x4*)(src + (size_t)(row0 + rr) * D + 8 * lane + 512 * j);
#pragma unroll
        for (int rr = 0; rr < 2; ++rr) { float a = 0.f;
#pragma unroll
            for (int j = 0; j < 2; ++j) unpack8(raw[rr][j], v[rr][2 * j], v[rr][2 * j + 1]);
#pragma unroll
            for (int q = 0; q < 4; ++q) a += (v[rr][q][0] * v[rr][q][0] + v[rr][q][1] * v[rr][q][1]) + (v[rr][q][2] * v[rr][q][2] + v[rr][q][3] * v[rr][q][3]);
            ss[rr] = a; }
#pragma unroll
        for (int rr = 0; rr < 2; ++rr) {
            const float r = rsqrtf(wave_sum(ss[rr], lane) * (1.0f / D) + EPS);
#pragma unroll
            for (int j = 0; j < 2; ++j) *(u32x4*)(dst + (size_t)(row0 + rr) * D + 8 * lane + 512 * j) = pack8(v[rr][2 * j] * r * wv[2 * j] + shv[2 * j], v[rr][2 * j + 1] * r * wv[2 * j + 1] + shv[2 * j + 1]);
        }
    }
}
__device__ __forceinline__ void norm_rows_ctx(const float* cx, const float* slab, bf16_t* dst, int nrows, const f32x4 (&wv)[4], const f32x4 (&shv)[4], int gw, int ngw, int lane) {
    for (int row = gw; row < nrows; row += ngw) {
        const size_t ro = (size_t)row * D + 4 * lane;
        f32x4 v[4]; float ss = 0.f;
#pragma unroll
        for (int j = 0; j < 4; ++j) { f32x4 a = *(const f32x4*)(cx + ro + 256 * j);
#pragma unroll
            for (int k = 0; k < 11; ++k) a += *(const f32x4*)(slab + (size_t)k * (TC * D) + ro + 256 * j);
            v[j] = a; ss += (a[0] * a[0] + a[1] * a[1]) + (a[2] * a[2] + a[3] * a[3]); }
        const float r = rsqrtf(wave_sum(ss, lane) * (1.0f / D) + EPS);
        bf16_t* d = dst + ro;
#pragma unroll
        for (int j = 0; j < 4; ++j) { const f32x4 y = v[j] * r * wv[j] + shv[j]; u32x2 o; o.x = pk2(y[0], y[1]); o.y = pk2(y[2], y[3]); *(u32x2*)(d + 256 * j) = o; }
    }
}
__device__ __forceinline__ void load_mod(const float* normw, const float* mods, int ms, int shidx, int lane, f32x4 (&wv)[4], f32x4 (&shv)[4]) {
#pragma unroll
    for (int j = 0; j < 4; ++j) { const int c = 4 * lane + 256 * j;
        const f32x4 w = *(const f32x4*)(normw + c), sc = *(const f32x4*)(mods + ms * (NMOD * D) + (shidx + 1) * D + c);
        shv[j] = *(const f32x4*)(mods + ms * (NMOD * D) + shidx * D + c); wv[j] = w * (sc + 1.0f); }
}

struct Params { const float* in[25]; float* out; unsigned char* ws; };

typedef const __attribute__((address_space(4))) Params* KParams;
#define PHASE_BEGIN \
    KParams pp = (KParams)__builtin_amdgcn_kernarg_segment_ptr(); asm volatile("" : "+s"(pp)); \
    unsigned char* ws = pp->ws; \
    int tid = threadIdx.x; asm volatile("" : "+v"(tid)); \
    const int lane = tid & 63, wid = __builtin_amdgcn_readfirstlane(tid >> 6), G = gridDim.x, bid = blockIdx.x, gw = bid * 8 + wid, ngw = G * 8; \
    const int vcu = (G % 8 == 0) ? (bid % 8) * (G / 8) + bid / 8 : bid;      \
    (void)lane; (void)wid; (void)gw; (void)ngw; (void)ws; (void)vcu;
constexpr int LDS_BAR_OFF = 140 * 1024;
#define GSYNC() do { KParams _p = (KParams)__builtin_amdgcn_kernarg_segment_ptr(); asm volatile("" : "+s"(_p)); \
    XcdBarrier _b; _b.bar = (unsigned*)(_p->ws + WS_BAR); _b.x = xb_xcc_id(); _b.st = (volatile LAS unsigned*)(lds + LDS_BAR_OFF); xcd_barrier(_b); } while (0)
#define GSYNC_CG() do { asm volatile("s_waitcnt vmcnt(0)" ::: "memory"); grid.sync(); \
    if (threadIdx.x == 0) { __builtin_amdgcn_fence(__ATOMIC_ACQUIRE, "agent"); asm volatile("s_waitcnt vmcnt(0)" ::: "memory"); } __syncthreads(); } while (0)
#define IN(i) (pp->in[i])
#define WSP(T_, off) ((T_*)(ws + (off)))

#define R0_PHASE() do { \
        { \
            PHASE_BEGIN \
            const float* mods = WSP(float, WS_MODS); bf16_t* xn = WSP(bf16_t, WS_XN); const bf16_t* hb = WSP(bf16_t, WS_H); \
            f32x4 wv[4], shv[4]; \
            load_mod8(IN(9), mods, 0, 3, lane, wv, shv); norm_rows_h(hb, xn, L, wv, shv, gw, ngw, lane); \
            load_mod8(IN(9), mods, 1, 3, lane, wv, shv); norm_rows_h(hb + (size_t)L * D, xn + (size_t)L * D, L, wv, shv, gw, ngw, lane); \
            load_mod(IN(9), mods, 2, 3, lane, wv, shv); norm_rows_ctx(IN(2), WSP(float, WS_SLAB), xn + (size_t)T * D, TC, wv, shv, gw, ngw, lane); \
        } \
    } while (0)

__global__ void __launch_bounds__(512, 2) fwd_megakernel(Params Parg) {
    extern __shared__ __attribute__((aligned(16))) unsigned char shm[];
    LAS unsigned char* lds = (LAS unsigned char*)shm;
    cg::grid_group grid = cg::this_grid();
    if (threadIdx.x < 4) ((volatile LAS unsigned*)(lds + LDS_BAR_OFF))[threadIdx.x] = 0u;
    __syncthreads();
    { KParams _p = (KParams)__builtin_amdgcn_kernarg_segment_ptr(); if (threadIdx.x == 0) (void)xb_add(&((unsigned*)(_p->ws + WS_BAR))[XB_XCNT(xb_xcc_id())], 1u); }

    {
        PHASE_BEGIN
        LAS float* scr = (LAS float*)(lds + wid * 8448);
        const float* w_mod = IN(4); const float* cvec = IN(1); const float* cctx = IN(3); float* part = WSP(float, WS_PART);
        constexpr int I_FI = 16 * (2 * DFF / 32), I_FO = (DFF / 64) * 32, I_IN = 16 * (INW / 32), I_RET = 32 * 32, I_SQ = 16 * 32;
        constexpr int NCONV = 2 * I_FI + 2 * I_FO + I_IN + I_RET + 2 * I_SQ, NMODI = 8 * 144;
        for (int it = gw; it < NCONV + NMODI; it += ngw) {
            int r = it;
            if (r >= NCONV) {
                r -= NCONV; const int kc = r / 144, nc = r % 144, n = nc * 64 + lane;
                float a0 = 0.f, a1 = 0.f, a2 = 0.f;
                for (int k = kc * 128; k < kc * 128 + 128; ++k) { const float w = __builtin_nontemporal_load(&w_mod[(size_t)k * (NMOD * D) + n]); a0 += fsilu(cvec[k]) * w; a1 += fsilu(cvec[D + k]) * w; a2 += fsilu(cctx[k]) * w; }
                part[(kc * 3 + 0) * (NMOD * D) + n] = a0; part[(kc * 3 + 1) * (NMOD * D) + n] = a1; part[(kc * 3 + 2) * (NMOD * D) + n] = a2;
                continue;
            }
            if (r < I_FI) { transpose_item(IN(7), D, 2 * DFF, WSP(bf16_t, WS_WFFN1IN), 1, scr, r, lane); continue; } r -= I_FI;
            if (r < I_FI) { transpose_item(IN(22), D, 2 * DFF, WSP(bf16_t, WS_WFFN2IN), 1, scr, r, lane); continue; } r -= I_FI;
            if (r < I_FO) { transpose_item(IN(8), DFF, D, WSP(bf16_t, WS_WFFN1OUT), 0, scr, r, lane); continue; } r -= I_FO;
            if (r < I_FO) { transpose_item(IN(23), DFF, D, WSP(bf16_t, WS_WFFN2OUT), 0, scr, r, lane); continue; } r -= I_FO;
            if (r < I_IN) { transpose_item(IN(10), D, INW, WSP(bf16_t, WS_WIN), 2, scr, r, lane); continue; } r -= I_IN;
            if (r < I_RET) { transpose_item(IN(14), 2048, D, WSP(bf16_t, WS_WRET), 0, scr, r, lane); continue; } r -= I_RET;
            if (r < I_SQ) { transpose_item(IN(19), D, D, WSP(bf16_t, WS_WCONV), 0, scr, r, lane); continue; } r -= I_SQ;
            transpose_item(IN(20), D, D, WSP(bf16_t, WS_WOUT), 0, scr, r, lane);
        }
        if (bid == 0 && tid < 8) { const float xl = tid < 4 ? IN(11)[tid] : IN(12)[tid - 4]; WSP(float, WS_DEC)[tid] = -log1pf(expf(-xl)) * 1.4426950408889634f; }
    }
    if (gridDim.x > 1024u) GSYNC_CG();
    GSYNC();
    {
        PHASE_BEGIN
        const float* x = IN(0); bf16_t* xn = WSP(bf16_t, WS_XN);
        const float* b_mod = IN(5); const float* part = WSP(float, WS_PART); float* mods = WSP(float, WS_MODS);
        for (int i = bid * 512 + tid; i < 3 * NMOD * D; i += G * 512) {
            const int ms = i / (NMOD * D), n = i % (NMOD * D); float a = b_mod[n];
#pragma unroll
            for (int p = 0; p < 8; ++p) a += part[(p * 3 + ms) * (NMOD * D) + n];
            mods[i] = a;
        }
        f32x4 wv[4], shv[4];
#pragma unroll 1
        for (int ms = 0; ms < 3; ++ms) {
#pragma unroll
            for (int j = 0; j < 4; ++j) { const int c = 4 * lane + 256 * j;
                f32x4 sh = *(const f32x4*)(b_mod + c), sc = *(const f32x4*)(b_mod + D + c);
#pragma unroll
                for (int p = 0; p < 8; ++p) { sh += *(const f32x4*)(part + (p * 3 + ms) * (NMOD * D) + c); sc += *(const f32x4*)(part + (p * 3 + ms) * (NMOD * D) + D + c); }
                shv[j] = sh; wv[j] = *(const f32x4*)(IN(6) + c) * (sc + 1.0f); }
            if (ms < 2) norm_rows(x + (size_t)ms * L * D, xn + (size_t)ms * L * D, L, wv, shv, gw, ngw, lane);
            else norm_rows(IN(2), xn + (size_t)T * D, TC, wv, shv, gw, ngw, lane);
        }
    }
    GSYNC();
    { PHASE_BEGIN
      GridSched S{(const char*)(ws + WS_XN), (const char*)(ws + WS_WFFN1IN), D * 2, D * 2, 16, MALL / 256, 2 * DFF / 256, G, bid}; EpiFfnIn E; E.act = WSP(bf16_t, WS_ACT); gemm_phase(lds, S, E); }
    GSYNC();
    { PHASE_BEGIN
      Ffn1OutSched S{(const char*)(ws + WS_ACT), (const char*)(ws + WS_WFFN1OUT), G, bid};
      EpiResid<false> E; E.res_f32 = IN(0); E.hbuf = WSP(bf16_t, WS_H); E.dst_ctx = WSP(float, WS_SLAB); E.mods = WSP(float, WS_MODS); E.gidx = 2; E.coef = 0.5f; gemm_phase(lds, S, E); }
    GSYNC();
    for (int b = 0; b < NB; ++b) {
        if (b == 0) { R0_PHASE(); GSYNC(); }
        { PHASE_BEGIN
          GridSched S{(const char*)(ws + WS_WIN + (size_t)1024 * D * 2), (const char*)(ws + WS_XN + (size_t)b * L * D * 2), D * 2, D * 2, 16, 12, L / 256, G, bid};
          EpiProjT E; E.ktf = WSP(bf16_t, WS_KTQK); E.ktb = WSP(bf16_t, WS_KTQK + 32 * MiB); E.vt = WSP(bf16_t, WS_VT); E.dec = WSP(float, WS_DEC); E.ld = L; E.clen = CH; E.rope = 1; gemm_phase(lds, S, E); }
        if (b == 0) { PHASE_BEGIN
          GridSched S{(const char*)(ws + WS_WIN + (size_t)1024 * D * 2), (const char*)(ws + WS_XN + (size_t)T * D * 2), D * 2, D * 2, 16, 12, 2, G, (bid + 128) % G};
          EpiProjT E; E.ktf = WSP(bf16_t, WS_CTX + CTX_KT); E.ktb = WSP(bf16_t, WS_CTX + CTX_KT + 512 * 1024); E.vt = WSP(bf16_t, WS_CTX + CTX_VT); E.dec = WSP(float, WS_DEC); E.ld = CTXL; E.clen = CTXL; E.rope = 0; gemm_phase(lds, S, E); }
        GSYNC();
        { PHASE_BEGIN
          USched S{(const char*)(ws + WS_VT), (const char*)(ws + WS_KTQK), (const char*)(ws + WS_KTQK + 32 * MiB), G, vcu}; EpiU E; E.sb = WSP(bf16_t, WS_SB); E.rfb = WSP(float, WS_CTX); E.ctx = 0; gemm_phase(lds, S, E); }
        if (b == 0) { PHASE_BEGIN
          UCtxSched S{(const char*)(ws + WS_CTX + CTX_VT), (const char*)(ws + WS_CTX + CTX_KT), (const char*)(ws + WS_CTX + CTX_KT + 512 * 1024), G, (bid + 64) % G}; EpiU E; E.sb = WSP(bf16_t, WS_SB); E.rfb = WSP(float, WS_CTX); E.ctx = 1; gemm_phase(lds, S, E); }
        GSYNC();
        {
            PHASE_BEGIN
            bf16_t* sb = WSP(bf16_t, WS_SB); const float* rfb = WSP(float, WS_CTX + (size_t)b * CTX_STRIDE); const float* dec = WSP(float, WS_DEC);
            for (int it = bid * 512 + tid; it < 4 * 512 * 2 * 32; it += G * 512) {
                const int dg = it & 31, dir = (it >> 5) & 1, e = (it >> 6) & 511, h = it >> 15;
                const float cdec = ex2((float)CH * dec[dir * 4 + h]);
                bf16_t* base = sb + ((size_t)(h * NCH) * 512 + e) * 512 + dir * 256 + dg * 8;
                const float* r0 = rfb + ((size_t)((h * 2 + dir) * 512 + e)) * 256 + dg * 8;
                f32x4 c0 = *(const f32x4*)r0, c1 = *(const f32x4*)(r0 + 4);
#pragma unroll 1
                for (int g16 = 0; g16 < NCH / 16; ++g16) {
                    u32x4 ldv[16];
                    bf16_t* bp = base + (size_t)(dir ? (NCH - 1 - g16 * 16) : g16 * 16) * (512 * 512);
                    const ptrdiff_t st = dir ? -(ptrdiff_t)(512 * 512) : (ptrdiff_t)(512 * 512);
#pragma unroll
                    for (int j = 0; j < 16; ++j) ldv[j] = *(const u32x4*)(bp + j * st);
#pragma unroll
                    for (int j = 0; j < 16; ++j) { f32x4 t0, t1; unpack8(ldv[j], t0, t1); *(u32x4*)(bp + j * st) = pack8(c0, c1); c0 = c0 * cdec + t0; c1 = c1 * cdec + t1; }
                }
            }
        }
        { PHASE_BEGIN
          GridSched S{(const char*)(ws + WS_XN + (size_t)b * L * D * 2), (const char*)(ws + WS_WIN), D * 2, D * 2, 16, L / 256, 8, G, bid}; EpiQK E; E.q = WSP(bf16_t, WS_KTQK); E.k = WSP(bf16_t, WS_KTQK + 32 * MiB); gemm_phase(lds, S, E); }
        GSYNC();
        for (int it5 = 0; it5 * (int)gridDim.x < NCH * 4 * 2; ++it5) {
            const int g5 = gridDim.x, b5 = blockIdx.x, item = it5 * g5 + ((g5 % 8 == 0) ? (b5 % 8) * (g5 / 8) + b5 / 8 : b5);
            if (item >= NCH * 4 * 2) break;
            { PHASE_BEGIN
              bf16_t* pscr = (bf16_t*)(ws + WS_PSCR + (size_t)(bid >> 1) * (256 * D * 2) + (size_t)(bid & 1) * (CH * 2));
              QKSched S{(const char*)(ws + WS_KTQK), (const char*)(ws + WS_KTQK + 32 * MiB), item}; EpiP E; E.pscr = pscr; E.dec = WSP(float, WS_DEC); gemm_phase(lds, S, E); }
            __builtin_amdgcn_fence(__ATOMIC_ACQUIRE, "agent");
            { PHASE_BEGIN
              bf16_t* pscr = (bf16_t*)(ws + WS_PSCR + (size_t)(bid >> 1) * (256 * D * 2) + (size_t)(bid & 1) * (CH * 2));
              const int ib = item & 1, h = (item >> 1) & 3, n = item >> 3;
              SVSched S{(const char*)(ws + WS_KTQK) + ((size_t)(n * CH + ib * 256) * D + h * 256) * 2, (const char*)(ws + WS_SB) + ((size_t)((h * NCH + n) * 512) * 512) * 2,
                        (const char*)(ws + WS_VT) + ((size_t)((h * NCH + n) * 512) * 512) * 2, (const char*)pscr, item};
              EpiSV E; E.o = (bf16_t*)pp->out + (size_t)b * L * 2048; E.dec = WSP(float, WS_DEC); gemm_phase(lds, S, E); }
        }
        GSYNC();
    }
    {
        PHASE_BEGIN
        const float* mods = WSP(float, WS_MODS); bf16_t* xn = WSP(bf16_t, WS_XN); const bf16_t* hb = WSP(bf16_t, WS_H); const bf16_t* ob = (const bf16_t*)pp->out;
        (void)mods; (void)xn; (void)hb;
        float* stats = WSP(float, WS_STATS);
        for (int row0 = gw * 2; row0 < T; row0 += ngw * 2) {
            u32x4 raw[2][4];
#pragma unroll
            for (int rr = 0; rr < 2; ++rr)
#pragma unroll
                for (int h = 0; h < 4; ++h) raw[rr][h] = *(const u32x4*)(ob + (size_t)(row0 + rr) * 2048 + h * 512 + lane * 8);
            float sm[8], sq[8]; f32x4 vv[8][2];
#pragma unroll
            for (int i = 0; i < 8; ++i) { unpack8(raw[i >> 2][i & 3], vv[i][0], vv[i][1]); sm[i] = (vv[i][0][0] + vv[i][0][1]) + (vv[i][0][2] + vv[i][0][3]) + (vv[i][1][0] + vv[i][1][1]) + (vv[i][1][2] + vv[i][1][3]); }
            wave_sum_n<8>(sm, lane);
#pragma unroll
            for (int i = 0; i < 8; ++i) { const float mu = sm[i] * (1.0f / 512.0f); const f32x4 d0 = vv[i][0] - mu, d1 = vv[i][1] - mu; sm[i] = mu;
                sq[i] = (d0[0] * d0[0] + d0[1] * d0[1]) + (d0[2] * d0[2] + d0[3] * d0[3]) + (d1[0] * d1[0] + d1[1] * d1[1]) + (d1[2] * d1[2] + d1[3] * d1[3]); }
            wave_sum_n<8>(sq, lane);
            if (lane == 0) {
#pragma unroll
                for (int i = 0; i < 8; ++i) { f32x2 st; st.x = sm[i]; st.y = rsqrtf(sq[i] * (1.0f / 512.0f) + EPS); *(f32x2*)(stats + ((size_t)(row0 + (i >> 2)) * 4 + (i & 3)) * 2) = st; }
            }
        }
    }
    GSYNC();
    { PHASE_BEGIN
      GridSched S{(const char*)(ws + WS_XN), (const char*)(ws + WS_WIN + (size_t)4096 * D * 2), D * 2, D * 2, 16, T / 256, 8, G, bid};
      EpiRg E; E.o = (bf16_t*)pp->out; E.stats = WSP(float, WS_STATS); E.gnw = IN(13); gemm_phase(lds, S, E); }
    { PHASE_BEGIN
      GridSched S{(const char*)(ws + WS_XN), (const char*)(ws + WS_WIN + (size_t)6144 * D * 2), D * 2, D * 2, 16, T / 256, 8, G, bid};
      EpiCv E; E.y = WSP(bf16_t, WS_Y); gemm_phase(lds, S, E); }
    GSYNC();
    { PHASE_BEGIN
      GridSched S{(const char*)pp->out, (const char*)(ws + WS_WRET), 2048 * 2, 2048 * 2, 32, T / 256, 4, G, bid}; EpiBf16 E; E.dst = WSP(bf16_t, WS_YR); E.ld = D; gemm_phase(lds, S, E); }
    {
        PHASE_BEGIN
        const bf16_t* yb = WSP(bf16_t, WS_Y); bf16_t* zb = WSP(bf16_t, WS_Z);
        LAS unsigned* ytile = (LAS unsigned*)lds;
        LAS float* red = (LAS float*)(lds + 62 * 2048);
        const float* cw = IN(15);
        f32x2 w2v[31];
#pragma unroll
        for (int w = 0; w < 31; ++w) w2v[w] = *(const f32x2*)(cw + w * D + 2 * tid);
        const f32x2 cb = *(const f32x2*)(IN(16) + 2 * tid), lw = *(const f32x2*)(IN(17) + 2 * tid), lb = *(const f32x2*)(IN(18) + 2 * tid);
#define CONV_LOAD(TILE) do { const int _bt = (TILE) / (L / 32), _t0 = ((TILE) % (L / 32)) * 32; int tl = tid; asm volatile("" : "+v"(tl));     \
            _Pragma("unroll 1") for (int kb = 0; kb < 16; kb += 4) { u32x4 stg[4]; \
            _Pragma("unroll") for (int k = 0; k < 4; ++k) { const int idx = tl + (kb + k) * 512, r = idx >> 7, c16 = idx & 127, l = _t0 - 15 + r; \
                stg[k] = (u32x4){0u, 0u, 0u, 0u}; if (idx < 62 * 128 && l >= 0 && l < L) stg[k] = *(const u32x4*)(yb + ((size_t)_bt * L + l) * D + c16 * 8); } \
            _Pragma("unroll") for (int k = 0; k < 4; ++k) { const int idx = tl + (kb + k) * 512, r = idx >> 7, c16 = idx & 127; if (idx < 62 * 128) *(LAS u32x4*)(ytile + r * 512 + c16 * 4) = stg[k]; } } } while (0)
        for (int tile = bid; tile < T / 32; tile += G) {
            const int bt = tile / (L / 32), t0 = (tile % (L / 32)) * 32;
            __syncthreads();
            CONV_LOAD(tile);
            __syncthreads();
#pragma unroll 1
            for (int sbk = 0; sbk < 2; ++sbk) {
                f32x2 a2[16];
#pragma unroll
                for (int tt = 0; tt < 16; ++tt) a2[tt] = cb;
#pragma unroll
                for (int w2 = 0; w2 < 46; ++w2) {
                    const unsigned pv = ytile[(sbk * 16 + w2) * 512 + tid]; f32x2 v; v.x = bflo(pv); v.y = bfhi(pv);
#pragma unroll
                    for (int tt = 0; tt < 16; ++tt) { const int w = w2 - tt; if (w >= 0 && w < 31) a2[tt] = __builtin_elementwise_fma(v, w2v[w], a2[tt]); }
                }
                LAS float* rd = red + (sbk & 1) * 256;
                { float r16[16];
#pragma unroll
                  for (int tt = 0; tt < 16; ++tt) r16[tt] = a2[tt].x + a2[tt].y;
                  const float tot = wave_reduce16(r16, lane);
#pragma unroll
                  for (int tt = 0; tt < 16; ++tt) r16[tt] = a2[tt].x * a2[tt].x + a2[tt].y * a2[tt].y;
                  const float tot2 = wave_reduce16(r16, lane);
                  const int ri = ((lane >> 5) & 1) * 8 + ((lane >> 4) & 1) * 4 + ((lane >> 3) & 1) * 2 + ((lane >> 2) & 1);
                  if ((lane & 3) == 0) { rd[wid * 32 + ri] = tot; rd[wid * 32 + 16 + ri] = tot2; } }
                __syncthreads();
                f32x4 tsum[8];
#pragma unroll
                for (int q4 = 0; q4 < 8; ++q4) tsum[q4] = (f32x4){0.f, 0.f, 0.f, 0.f};
#pragma unroll
                for (int wv8 = 0; wv8 < 8; ++wv8)
#pragma unroll
                    for (int q4 = 0; q4 < 8; ++q4) tsum[q4] += *(const LAS f32x4*)(rd + wv8 * 32 + q4 * 4);
#pragma unroll
                for (int tt = 0; tt < 16; ++tt) {
                    const float t1 = tsum[tt >> 2][tt & 3], t2 = tsum[4 + (tt >> 2)][tt & 3];
                    const float mu = t1 * (1.0f / D), var = fmaxf(t2 * (1.0f / D) - mu * mu, 0.f), rs = rsqrtf(var + EPS);
                    const float z0 = fsilu((a2[tt].x - mu) * rs * lw.x + lb.x), z1 = fsilu((a2[tt].y - mu) * rs * lw.y + lb.y);
                    *(unsigned*)(zb + ((size_t)bt * L + t0 + sbk * 16 + tt) * D + 2 * tid) = pk2(z0, z1);
                }
            }
        }
        __syncthreads();
    }
    GSYNC();
    { PHASE_BEGIN
      GridSched S{(const char*)(ws + WS_Z), (const char*)(ws + WS_WCONV), D * 2, D * 2, 16, T / 256, 4, G, bid}; EpiBf16 E; E.dst = WSP(bf16_t, WS_YC); E.ld = D; gemm_phase(lds, S, E); }
    GSYNC();
    { PHASE_BEGIN
      GridSched S{(const char*)(ws + WS_XN), (const char*)(ws + WS_WIN + (size_t)8192 * D * 2), D * 2, D * 2, 16, T / 256, 8, G, bid}; EpiGab E; E.yr = WSP(bf16_t, WS_YR); E.yc = WSP(bf16_t, WS_YC); gemm_phase(lds, S, E); }
    GSYNC();
    { PHASE_BEGIN
      GridSched S{(const char*)(ws + WS_YR), (const char*)(ws + WS_WOUT), D * 2, D * 2, 16, T / 256, 4, G, bid};
      EpiResid<true> E; E.res_f32 = nullptr; E.hbuf = WSP(bf16_t, WS_H); E.dst_ctx = nullptr; E.mods = WSP(float, WS_MODS); E.gidx = 5; E.coef = 1.0f; gemm_phase(lds, S, E); }
    GSYNC();
    {
        PHASE_BEGIN
        const float* mods = WSP(float, WS_MODS); bf16_t* xn = WSP(bf16_t, WS_XN); const bf16_t* hb = WSP(bf16_t, WS_H);
        f32x4 wv[4], shv[4];
        load_mod8(IN(21), mods, 0, 6, lane, wv, shv); norm_rows_h(hb, xn, L, wv, shv, gw, ngw, lane);
        load_mod8(IN(21), mods, 1, 6, lane, wv, shv); norm_rows_h(hb + (size_t)L * D, xn + (size_t)L * D, L, wv, shv, gw, ngw, lane);
    }
    GSYNC();
    { PHASE_BEGIN
      GridSched S{(const char*)(ws + WS_XN), (const char*)(ws + WS_WFFN2IN), D * 2, D * 2, 16, T / 256, 2 * DFF / 256, G, bid}; EpiFfnIn E; E.act = WSP(bf16_t, WS_ACT); gemm_phase(lds, S, E); }
    GSYNC();
    { PHASE_BEGIN
      GridSched S{(const char*)(ws + WS_ACT), (const char*)(ws + WS_WFFN2OUT), DFF * 2, DFF * 2, DFF / 64, T / 256, 4, G, bid};
      EpiResid<true> E; E.res_f32 = nullptr; E.hbuf = WSP(bf16_t, WS_H); E.dst_ctx = nullptr; E.mods = WSP(float, WS_MODS); E.gidx = 8; E.coef = 0.5f; gemm_phase(lds, S, E); }
    GSYNC();
    {
        PHASE_BEGIN
        const float* fw = IN(24); float* out = pp->out; const bf16_t* hb = WSP(bf16_t, WS_H);
        f32x4 wv[4];
#pragma unroll
        for (int j = 0; j < 2; ++j)
#pragma unroll
            for (int q = 0; q < 2; ++q) wv[2 * j + q] = *(const f32x4*)(fw + 8 * lane + 512 * j + 4 * q);
        for (int row0 = gw * 2; row0 < T; row0 += ngw * 2) {
            u32x4 raw[2][2];
#pragma unroll
            for (int rr = 0; rr < 2; ++rr)
#pragma unroll
                for (int j = 0; j < 2; ++j) raw[rr][j] = __builtin_nontemporal_load((const u32x4*)(hb + (size_t)(row0 + rr) * D + 8 * lane + 512 * j));
#pragma unroll
            for (int rr = 0; rr < 2; ++rr) {
                f32x4 v[4]; float ss = 0.f;
#pragma unroll
                for (int j = 0; j < 2; ++j) unpack8(raw[rr][j], v[2 * j], v[2 * j + 1]);
#pragma unroll
                for (int q = 0; q < 4; ++q) ss += (v[q][0] * v[q][0] + v[q][1] * v[q][1]) + (v[q][2] * v[q][2] + v[q][3] * v[q][3]);
                const float r = rsqrtf(wave_sum(ss, lane) * (1.0f / D) + EPS);
                float* o = out + (size_t)(row0 + rr) * D + 8 * lane;
#pragma unroll
                for (int j = 0; j < 2; ++j) { __builtin_nontemporal_store(v[2 * j] * r * wv[2 * j], (f32x4*)(o + 512 * j)); __builtin_nontemporal_store(v[2 * j + 1] * r * wv[2 * j + 1], (f32x4*)(o + 512 * j + 4)); }
            }
        }
    }
}

constexpr int LDS_BYTES = 144 * 1024;

extern "C" void kernel_launch(void* const* d_in, const int* in_sizes, int n_in, void* d_out, int out_size, void* d_ws, size_t ws_size, hipStream_t stream) {
    static int grid_blocks = 0;
    if (grid_blocks == 0) {
        if (n_in != 25 || out_size != T * D || ws_size < WS_END) { fprintf(stderr, "kernel_launch: unexpected shapes (n_in %d out %d ws %zu need %zu)\n", n_in, out_size, ws_size, (size_t)WS_END); grid_blocks = -1; return; }
        int dev = 0, cus = 0, per_cu = 0;
        hipGetDevice(&dev);
        hipDeviceGetAttribute(&cus, hipDeviceAttributeMultiprocessorCount, dev);
        if (hipFuncSetAttribute((const void*)fwd_megakernel, hipFuncAttributeMaxDynamicSharedMemorySize, LDS_BYTES) != hipSuccess) { fprintf(stderr, "kernel_launch: hipFuncSetAttribute failed\n"); grid_blocks = -1; return; }
        if (hipOccupancyMaxActiveBlocksPerMultiprocessor(&per_cu, (const void*)fwd_megakernel, 512, LDS_BYTES) != hipSuccess || per_cu < 1) { fprintf(stderr, "kernel_launch: occupancy query says %d blocks per CU\n", per_cu); grid_blocks = -1; return; }
        grid_blocks = cus;
        if (grid_blocks > 256) grid_blocks = 256;
    }
    if (grid_blocks < 0) return;
    if (hipMemsetAsync((char*)d_ws + WS_BAR, 0, XCD_BAR_WORDS * sizeof(unsigned), stream) != hipSuccess) { fprintf(stderr, "kernel_launch: memset of the barrier words failed\n"); return; }
    Params p{};
    for (int i = 0; i < 25; ++i) p.in[i] = (const float*)d_in[i];
    p.out = (float*)d_out; p.ws = (unsigned char*)d_ws;
    void* args[] = {&p};
    hipError_t e = hipLaunchCooperativeKernel((const void*)fwd_megakernel, dim3(grid_blocks), dim3(512), args, LDS_BYTES, stream);
    if (e != hipSuccess) fprintf(stderr, "cooperative launch failed: %s (grid %d)\n", hipGetErrorString(e), grid_blocks);
}
```
